# Optimizing an MI355X kernel written in HIP

```python
import jax, jax.numpy as jnp
from jax import lax
import numpy as np

D_MODEL = 1024
BATCH = 8
SEQ = 8192
DEPTH = 1

GLA_HEADS = 4
GLA_DK = 64
GLA_DV = 128
GLA_GATE_RANK = 16
GLA_TAU = 16.0
GLA_CHUNK = 64
SWA_HEADS = 8
SWA_KV_HEADS = 2
SWA_HD = 64
SWA_WINDOW = 128
SWA_BLOCK = 128
ROPE_THETA = 500000.0
ROPE_DIM = SWA_HD // 4
D_FF = 2816
CONV_WIDTH = 3
EPS = 1e-6
MAX_POS_OFFSET = 4096

GLA_QK = GLA_HEADS * GLA_DK
GLA_V = GLA_HEADS * GLA_DV
SWA_Q = SWA_HEADS * SWA_HD
SWA_KV = SWA_KV_HEADS * SWA_HD
MIX_WIDTH = GLA_V + SWA_Q
IN_SPLITS = (GLA_QK, GLA_QK, GLA_V, GLA_GATE_RANK, GLA_V, SWA_Q, SWA_KV, SWA_KV)
IN_WIDTH = GLA_QK * 2 + GLA_V * 2 + GLA_GATE_RANK + SWA_Q + SWA_KV * 2

kernel_name = "hymba_gla_swa_sink_convffn_sandwich"


def rmsnorm(x, w):
    xf = x.astype(jnp.float32)
    y = xf * lax.rsqrt(jnp.mean(xf * xf, axis=-1, keepdims=True) + EPS)
    return (y * w.astype(jnp.float32)).astype(x.dtype)


def partial_rotary(x, positions):
    half = ROPE_DIM // 2
    inv_freq = ROPE_THETA ** (-jnp.arange(half, dtype=jnp.float32) * (2.0 / ROPE_DIM))
    ang = positions.astype(jnp.float32)[..., None] * inv_freq
    cos = jnp.cos(ang)[:, :, None, :]
    sin = jnp.sin(ang)[:, :, None, :]
    xr = x[..., :ROPE_DIM].astype(jnp.float32)
    x1, x2 = xr[..., :half], xr[..., half:]
    rot = jnp.concatenate([x1 * cos - x2 * sin, x2 * cos + x1 * sin], axis=-1)
    return jnp.concatenate([rot.astype(x.dtype), x[..., ROPE_DIM:]], axis=-1)


def gla_chunked(q, k, v, log_a):
    B, T, H, dk = q.shape
    dv = v.shape[-1]
    C = GLA_CHUNK
    n = T // C

    def to_chunks(t):
        return t.reshape(B, n, C, H, t.shape[-1]).transpose(1, 0, 3, 2, 4).astype(jnp.float32)

    qc = to_chunks(q * (dk ** -0.5))
    kc, vc, gc = to_chunks(k), to_chunks(v), to_chunks(log_a)
    causal = jnp.tril(jnp.ones((C, C), dtype=bool))[:, :, None]

    def step(S, inp):
        qi, ki, vi, gi = inp
        b = jnp.cumsum(gi, axis=2)
        o_inter = jnp.einsum('bhcd,bhde->bhce', qi * jnp.exp(b), S)
        diff = b[:, :, :, None, :] - b[:, :, None, :, :]
        decay = jnp.exp(jnp.where(causal, diff, -jnp.inf))
        A = jnp.einsum('bhid,bhjd,bhijd->bhij', qi, ki, decay)
        o_intra = jnp.einsum('bhij,bhje->bhie', A, vi)
        b_last = b[:, :, -1:, :]
        S_new = jnp.exp(b_last[:, :, 0, :])[..., None] * S + jnp.einsum(
            'bhcd,bhce->bhde', ki * jnp.exp(b_last - b), vi)
        return S_new, o_inter + o_intra

    S0 = jnp.zeros((B, H, dk, dv), jnp.float32)
    _, o = lax.scan(step, S0, (qc, kc, vc, gc))
    return o.transpose(1, 0, 3, 2, 4).reshape(B, T, H, dv).astype(v.dtype)


def swa_sink_attention(q, k, v, sinks):
    B, T, Hq, hd = q.shape
    Hkv = k.shape[2]
    G = Hq // Hkv
    W = SWA_BLOCK
    n = T // W
    qb = q.reshape(B, n, W, Hkv, G, hd).astype(jnp.float32)

    def with_prev(t):
        tb = t.reshape(B, n, W, Hkv, hd).astype(jnp.float32)
        prev = jnp.pad(tb, ((0, 0), (1, 0), (0, 0), (0, 0), (0, 0)))[:, :-1]
        return jnp.concatenate([prev, tb], axis=2)

    kb, vb = with_prev(k), with_prev(v)
    s = jnp.einsum('bnqhgd,bnshd->bhgnqs', qb, kb) * (hd ** -0.5)
    blk = jnp.arange(n)[:, None, None]
    qpos = blk * W + jnp.arange(W)[None, :, None]
    kpos = (blk - 1) * W + jnp.arange(2 * W)[None, None, :]
    mask = (kpos <= qpos) & (kpos > qpos - SWA_WINDOW) & (kpos >= 0)
    s = jnp.where(mask, s, -jnp.inf)
    sink = sinks.astype(jnp.float32).reshape(Hkv, G)[None, :, :, None, None]
    m = jnp.maximum(s.max(axis=-1), sink)
    p = jnp.exp(s - m[..., None])
    denom = p.sum(axis=-1) + jnp.exp(sink - m)
    o = jnp.einsum('bhgnqs,bnshd->bnqhgd', p, vb) / denom.transpose(0, 3, 4, 1, 2)[..., None]
    return o.reshape(B, T, Hq * hd).astype(q.dtype)


def causal_depthwise_conv(h, w, b):
    T = h.shape[1]
    hp = jnp.pad(h, ((0, 0), (CONV_WIDTH - 1, 0), (0, 0)))
    out = b
    for j in range(CONV_WIDTH):
        out = out + w[j] * hp[:, j:j + T]
    return out


def setup_inputs(seed: int = 0) -> dict:
    key = jax.random.key(seed)
    ks = jax.random.split(key, 18)
    nrm = jax.random.normal
    f32 = jnp.float32
    x = nrm(ks[0], (BATCH, SEQ, D_MODEL), f32)
    offs = jax.random.randint(ks[1], (BATCH, 1), 0, MAX_POS_OFFSET, dtype=jnp.int32)
    positions = (offs + jnp.arange(SEQ, dtype=jnp.int32)[None, :]).astype(jnp.int32)
    gain = lambda k_, d: 1.0 + 0.05 * nrm(k_, (DEPTH, d), f32)
    return {
        "x": x,
        "positions": positions,
        "pre_mix_norm": gain(ks[2], D_MODEL),
        "w_in": nrm(ks[3], (DEPTH, D_MODEL, IN_WIDTH), f32) * D_MODEL ** -0.5,
        "gla_gate_up": nrm(ks[4], (DEPTH, GLA_GATE_RANK, GLA_QK), f32) * GLA_GATE_RANK ** -0.5,
        "gla_gate_bias": 0.1 * nrm(ks[5], (DEPTH, GLA_QK), f32),
        "gla_out_norm": gain(ks[6], GLA_DV),
        "swa_sinks": nrm(ks[7], (DEPTH, SWA_HEADS), f32),
        "w_out": nrm(ks[8], (DEPTH, MIX_WIDTH, D_MODEL), f32) * MIX_WIDTH ** -0.5,
        "post_mix_norm": gain(ks[9], D_MODEL),
        "pre_ffn_norm": gain(ks[10], D_MODEL),
        "w_up": nrm(ks[11], (DEPTH, D_MODEL, 2 * D_FF), f32) * D_MODEL ** -0.5,
        "conv_w": nrm(ks[12], (DEPTH, CONV_WIDTH, 2 * D_FF), f32) * CONV_WIDTH ** -0.5,
        "conv_b": 0.02 * nrm(ks[13], (DEPTH, 2 * D_FF), f32),
        "w_down": nrm(ks[14], (DEPTH, D_FF, D_MODEL), f32) * D_FF ** -0.5,
        "post_ffn_norm": gain(ks[15], D_MODEL),
    }


def reference(x, positions, pre_mix_norm, w_in, gla_gate_up, gla_gate_bias, gla_out_norm,
              swa_sinks, w_out, post_mix_norm, pre_ffn_norm, w_up, conv_w, conv_b, w_down,
              post_ffn_norm):
    B, T, _ = x.shape
    split_points = np.cumsum(IN_SPLITS)[:-1].tolist()
    for l in range(DEPTH):
        h = rmsnorm(x, pre_mix_norm[l])
        proj = h @ w_in[l]
        gq, gk, gv, glr, gg, sq, sk, sv = jnp.split(proj, split_points, axis=-1)

        gate_logits = (glr @ gla_gate_up[l] + gla_gate_bias[l]).astype(jnp.float32)
        log_a = (jax.nn.log_sigmoid(gate_logits) / GLA_TAU).reshape(B, T, GLA_HEADS, GLA_DK)
        o_gla = gla_chunked(gq.reshape(B, T, GLA_HEADS, GLA_DK),
                            gk.reshape(B, T, GLA_HEADS, GLA_DK),
                            gv.reshape(B, T, GLA_HEADS, GLA_DV), log_a)
        o_gla = rmsnorm(o_gla, gla_out_norm[l]) * jax.nn.silu(gg.reshape(B, T, GLA_HEADS, GLA_DV))
        o_gla = o_gla.reshape(B, T, GLA_V)

        q = partial_rotary(sq.reshape(B, T, SWA_HEADS, SWA_HD), positions)
        k = partial_rotary(sk.reshape(B, T, SWA_KV_HEADS, SWA_HD), positions)
        v = sv.reshape(B, T, SWA_KV_HEADS, SWA_HD)
        o_swa = swa_sink_attention(q, k, v, swa_sinks[l])

        mix = jnp.concatenate([o_gla, o_swa], axis=-1) @ w_out[l]
        x = x + rmsnorm(mix, post_mix_norm[l])

        h = rmsnorm(x, pre_ffn_norm[l])
        u = causal_depthwise_conv(h @ w_up[l], conv_w[l], conv_b[l])
        val, gate = jnp.split(u, 2, axis=-1)
        y = (jax.nn.gelu(gate, approximate=True) * val) @ w_down[l]
        x = x + rmsnorm(y, post_ffn_norm[l])
    return x
```

```cpp
#include <hip/hip_runtime.h>
#include <hip/hip_cooperative_groups.h>
#include <cstdio>
#include <cstdint>
namespace cg = cooperative_groups;

#ifndef MK_ONE_LAUNCH
#define MK_ONE_LAUNCH 1
#endif

constexpr int BATCH = 8, SEQ = 8192, DM = 1024, M = BATCH * SEQ;
constexpr int IN_W = 2320, NIN = 2560;
constexpr int DFF = 2816, NUP = 2 * DFF;
constexpr float EPS = 1e-6f;
constexpr float LOG2E = 1.4426950408889634f;
constexpr float QSCALE = 0.125f * LOG2E;
constexpr int UP_TILE = 254, UP_MT = 33, UP_NT = 22, UP_UNITS = BATCH * UP_MT * UP_NT;

constexpr size_t MiB = 1u << 20;
constexpr size_t WS_CTL = 0, CTL_ZERO_BYTES = 1 * MiB;
constexpr size_t WS_WIN = 2 * MiB, WS_WOUT = 7 * MiB, WS_WUP = 9 * MiB, WS_WDN = 20 * MiB;
constexpr size_t WS_ROPE = 26 * MiB, WS_RS0 = 30 * MiB, WS_RS1 = 30 * MiB + 512 * 1024, WS_PART = 31 * MiB;
constexpr size_t WS_XB = 64 * MiB;
constexpr size_t WS_GQ = 192 * MiB, WS_GK = 224 * MiB, WS_GV = 256 * MiB, WS_LA = 320 * MiB, WS_GG = 384 * MiB, WS_SQ = 448 * MiB, WS_SK = 512 * MiB, WS_SV = 528 * MiB;
constexpr size_t WS_ACT = 192 * MiB;
constexpr size_t WS_U = 544 * MiB;
constexpr size_t WS_S = 672 * MiB;
constexpr size_t WS_MIX = 736 * MiB;
constexpr size_t WS_X1B = 864 * MiB;
constexpr size_t WS_END = 1024 * MiB;

namespace pg8 {
#define PG8_LAS __attribute__((address_space(3)))
typedef unsigned short bf16_t;
typedef short bf16x8 __attribute__((ext_vector_type(8)));
typedef float f32x4 __attribute__((ext_vector_type(4)));
typedef unsigned u32x4 __attribute__((ext_vector_type(4)));
constexpr int BM = 256, BK = 64, HALF = 128, HTB = HALF * BK * 2, STAGE_BYTES = 8 * HTB, NXCD = 8, WGM = 8;

__host__ __device__ __forceinline__ int lds_byte(int r, int c) { const int st = (r >> 4) * 2 + (c >> 5), rr = r & 15, cc = c & 31, ob = rr * 64 + cc * 2; return st * 1024 + (ob ^ (((ob >> 9) & 1) << 5)); }
__host__ __device__ __forceinline__ void stage_rc(int b, int& R, int& C) { const int st = b / 1024, sb = b % 1024, swz = sb ^ (((sb >> 9) & 1) << 5); R = (st >> 1) * 16 + swz / 64; C = (st & 1) * 32 + (swz % 64) / 2; }
__host__ __device__ __forceinline__ int perm32(int rho) { const int n = rho >> 4, i = rho & 15; return 8 * (i >> 2) + 4 * n + (i & 3); }

struct Unit { int pm, pn, arow, aux; };
struct Gemm { const bf16_t* A; const bf16_t* Bt; int K; };

struct StaticOrder {
    int nM, nN, nwg, G, c;
    __device__ void init(int M_, int N_, int G_, int c_) { nM = M_ / BM; nN = N_ / BM; nwg = nM * nN; G = G_; c = c_; }
    __device__ bool next(int i, Unit& u) const {
        const long L = (long)i * G + c; if (L >= nwg) return false;
        int wgid = (int)L; { const int q = nwg / NXCD, r = nwg % NXCD, xcd = wgid % NXCD, off = wgid / NXCD; wgid = (xcd < r ? xcd * (q + 1) : r * (q + 1) + (xcd - r) * q) + off; }
        const int nig = WGM * nN, gid = wgid / nig, fm = gid * WGM, gsz = (nM - fm) < WGM ? (nM - fm) : WGM;
        u.pm = fm + ((wgid % nig) % gsz); u.pn = (wgid % nig) / gsz; u.arow = u.pm * BM; u.aux = 0; return true;
    }
};
struct UpOrder {
    int G, c;
    __device__ bool next(int i, Unit& u) const {
        const long L = (long)i * G + c; if (L >= UP_UNITS) return false;
        const int seq = (int)(L % 8), off = (int)(L / 8);
        const int nig = WGM * UP_NT, gid = off / nig, fm = gid * WGM, gsz = (UP_MT - fm) < WGM ? (UP_MT - fm) : WGM, rem = off % nig;
        u.pm = fm + rem % gsz; u.pn = rem / gsz;
        int t0 = u.pm * UP_TILE; if (t0 > SEQ - UP_TILE) t0 = SEQ - UP_TILE;
        u.arow = seq * SEQ + t0 - 2; u.aux = t0 - 2; return true;
    }
};

__device__ __forceinline__ unsigned cvt_pk_bf16(float lo, float hi) { unsigned r; asm volatile("v_cvt_pk_bf16_f32 %0, %1, %2" : "=v"(r) : "v"(lo), "v"(hi)); return r; }
__device__ __forceinline__ u32x4 pack8(const f32x4& v0, const f32x4& v1) { u32x4 w; w.x = cvt_pk_bf16(v0[0], v0[1]); w.y = cvt_pk_bf16(v0[2], v0[3]); w.z = cvt_pk_bf16(v1[0], v1[1]); w.w = cvt_pk_bf16(v1[2], v1[3]); return w; }
__device__ __forceinline__ float sigmoidf_(float v) { return __builtin_amdgcn_rcpf(1.0f + __builtin_amdgcn_exp2f(-v * LOG2E)); }
__device__ __forceinline__ float shx(float v, int m) { return __shfl_xor(v, m); }


struct EpiIn {
    static constexpr bool PERM = true;
    const float* rs0; const float* rope; const float* gbias;
    bf16_t *gq, *gk, *gv, *gg, *sq, *sk, *sv; float* la;
    __device__ __forceinline__ void operator()(f32x4 (&acc)[2][2][4][2], const Unit& u, int wr, int wc, int fr, int fq, PG8_LAS unsigned char*) const {
        asm volatile("" : "+v"(fr), "+v"(fq));
        const int pn = u.pn, cw = 32 * wc + 8 * fq, row0 = u.arow + wr * 64 + fr;
        if (pn == 4) {
            f32x4 bv[2][2];
#pragma unroll
            for (int bj = 0; bj < 2; ++bj)
#pragma unroll
                for (int n = 0; n < 2; ++n) bv[bj][n] = *(const f32x4*)(gbias + bj * HALF + cw + 4 * n);
#pragma unroll
            for (int ai = 0; ai < 2; ++ai)
#pragma unroll
                for (int m = 0; m < 4; ++m) { const int row = row0 + ai * HALF + m * 16; const float s = rs0[row];
#pragma unroll
                    for (int bj = 0; bj < 2; ++bj)
#pragma unroll
                        for (int n = 0; n < 2; ++n) { f32x4 v = acc[ai][bj][m][n] * s + bv[bj][n], o;
#pragma unroll
                            for (int e = 0; e < 4; ++e) { const float x = v[e], ex = __builtin_amdgcn_exp2f(-__builtin_fabsf(x) * LOG2E);
                                o[e] = (__builtin_fminf(x, 0.f) - __builtin_amdgcn_logf(1.0f + ex) * 0.6931471805599453f) * (1.0f / 16.0f); }
                            *(f32x4*)(la + (size_t)row * 256 + bj * HALF + cw + 4 * n) = o; } }
            return;
        }
        bf16_t* dst0; bf16_t* dst1; int ld; float sc = 1.f; bool rot0 = false, rot1 = false, silu = false;
        if (pn == 0) { dst0 = gq; dst1 = gq + HALF; ld = 256; sc = 0.125f; }
        else if (pn == 1) { dst0 = gk; dst1 = gk + HALF; ld = 256; }
        else if (pn <= 3) { dst0 = gv + (pn - 2) * 256; dst1 = dst0 + HALF; ld = 512; }
        else if (pn <= 6) { dst0 = gg + (pn - 5) * 256; dst1 = dst0 + HALF; ld = 512; silu = true; }
        else if (pn <= 8) { dst0 = sq + (pn - 7) * 256; dst1 = dst0 + HALF; ld = 512; rot0 = rot1 = true; sc = QSCALE; }
        else { dst0 = sk; dst1 = sv; ld = 128; rot0 = true; }
        const bool rw = (wc & 1) == 0;
        const float sgn = (fq == 0) ? -1.f : 1.f;
#pragma unroll
        for (int ai = 0; ai < 2; ++ai)
#pragma unroll
            for (int m = 0; m < 4; ++m) { const int row = row0 + ai * HALF + m * 16; const float s = rs0[row];
                f32x4 c0, c1, s0, s1;
                if (rot0 && rw) { const float* rp = rope + (size_t)row * 16; c0 = *(const f32x4*)(rp); c1 = *(const f32x4*)(rp + 4); s0 = *(const f32x4*)(rp + 8); s1 = *(const f32x4*)(rp + 12); }
#pragma unroll
                for (int bj = 0; bj < 2; ++bj) { f32x4 v0 = acc[ai][bj][m][0] * s, v1 = acc[ai][bj][m][1] * s;
                    if (silu) {
#pragma unroll
                        for (int e = 0; e < 4; ++e) { v0[e] = v0[e] * sigmoidf_(v0[e]); v1[e] = v1[e] * sigmoidf_(v1[e]); } }
                    if ((bj == 0 ? rot0 : rot1) && rw) { f32x4 p0, p1;
#pragma unroll
                        for (int e = 0; e < 4; ++e) { p0[e] = shx(v0[e], 16); p1[e] = shx(v1[e], 16); }
                        if (fq < 2) { v0 = v0 * c0 + (p0 * s0) * sgn; v1 = v1 * c1 + (p1 * s1) * sgn; } }
                    v0 = v0 * sc; v1 = v1 * sc;
                    *(u32x4*)((bj == 0 ? dst0 : dst1) + (size_t)row * ld + cw) = pack8(v0, v1); } }
    }
};

struct EpiY {
    static constexpr bool PERM = true;
    bf16_t* y; float* part;
    __device__ __forceinline__ void operator()(f32x4 (&acc)[2][2][4][2], const Unit& u, int wr, int wc, int fr, int fq, PG8_LAS unsigned char*) const {
        asm volatile("" : "+v"(fr), "+v"(fq));
        const int row0 = u.arow + wr * 64 + fr, col0 = u.pn * BM + wc * 32 + 8 * fq;
#pragma unroll
        for (int ai = 0; ai < 2; ++ai)
#pragma unroll
            for (int m = 0; m < 4; ++m) { const int row = row0 + ai * HALF + m * 16; float ss = 0.f;
#pragma unroll
                for (int bj = 0; bj < 2; ++bj) { const f32x4 v0 = acc[ai][bj][m][0], v1 = acc[ai][bj][m][1];
                    ss += (v0[0] * v0[0] + v0[1] * v0[1]) + (v0[2] * v0[2] + v0[3] * v0[3]) + (v1[0] * v1[0] + v1[1] * v1[1]) + (v1[2] * v1[2] + v1[3] * v1[3]);
                    *(u32x4*)(y + (size_t)row * DM + col0 + bj * HALF) = pack8(v0, v1); }
                ss += shx(ss, 16); ss += shx(ss, 32);
                if (fq == 0) part[(size_t)row * 16 + u.pn * 4 + wc] = ss; }
    }
};

struct EpiUp {
    static constexpr bool PERM = true;
    bf16_t* act; const float* rs1; const float* cw; const float* cb;
    __device__ __forceinline__ void operator()(f32x4 (&acc)[2][2][4][2], const Unit& u, int wr, int wc, int fr, int fq, PG8_LAS unsigned char* xl) const {
        asm volatile("" : "+v"(fr), "+v"(fq));
#pragma unroll
        for (int ai = 0; ai < 2; ++ai)
#pragma unroll
            for (int m = 0; m < 4; ++m) { const float s = rs1[u.arow + ai * HALF + wr * 64 + m * 16 + fr];
#pragma unroll
                for (int bj = 0; bj < 2; ++bj)
#pragma unroll
                    for (int n = 0; n < 2; ++n) acc[ai][bj][m][n] = acc[ai][bj][m][n] * s; }
        asm volatile("" ::: "memory");
        PG8_LAS f32x4* X = (PG8_LAS f32x4*)xl;
        if (fr >= 14) {
#pragma unroll
            for (int ai = 0; ai < 2; ++ai)
#pragma unroll
                for (int bj = 0; bj < 2; ++bj)
#pragma unroll
                    for (int n = 0; n < 2; ++n) X[((((ai * 2 + wr) * 4 + wc) * 2 + (fr - 14)) * 4 + fq) * 4 + bj * 2 + n] = acc[ai][bj][3][n];
        }
        asm volatile("s_waitcnt lgkmcnt(0)" ::: "memory"); __builtin_amdgcn_s_barrier(); asm volatile("" ::: "memory");
#define DPPF(v, ctrl) __int_as_float(__builtin_amdgcn_update_dpp(0, __float_as_int(v), (ctrl), 0xf, 0xf, true))
        const int colv = u.pn * HALF + wc * 32 + 8 * fq;
        const f32x4 zero4 = (f32x4){0.f, 0.f, 0.f, 0.f};
#pragma unroll
        for (int bj = 0; bj < 2; ++bj) {
#pragma unroll
            for (int n = 0; n < 2; ++n) { const int c = bj * DFF + colv + 4 * n;
                const f32x4 pb = *(const f32x4*)(cb + c), p0 = *(const f32x4*)(cw + c), p1 = *(const f32x4*)(cw + NUP + c), p2 = *(const f32x4*)(cw + 2 * NUP + c);
#pragma unroll
                for (int ai = 0; ai < 2; ++ai) {
                    const bool has = !(wr == 0 && ai == 0);
                    const int pai = (wr == 1) ? ai : ai - 1, pwr = (wr == 1) ? 0 : 1;
                    f32x4 prev = zero4;
                    if (has && fr >= 14) prev = X[((((pai * 2 + pwr) * 4 + wc) * 2 + (fr - 14)) * 4 + fq) * 4 + bj * 2 + n];
#pragma unroll
                    for (int m = 0; m < 4; ++m) {
                        const f32x4 cur = acc[ai][bj][m][n]; f32x4 q1, q2;
#pragma unroll
                        for (int e = 0; e < 4; ++e) { q1[e] = DPPF(cur[e], 0x111) + DPPF(prev[e], 0x10F); q2[e] = DPPF(cur[e], 0x112) + DPPF(prev[e], 0x10E); }
                        const int t = u.aux + ai * HALF + wr * 64 + m * 16 + fr;
                        if (t < 1) q1 = zero4;
                        if (t < 2) q2 = zero4;
                        acc[ai][bj][m][n] = pb + p0 * q2 + p1 * q1 + p2 * cur;
                        asm volatile("" : "+v"(acc[ai][bj][m][n]));
                        prev = cur;
                    }
                    asm volatile("" ::: "memory");
                }
            }
        }
#undef DPPF
#pragma unroll
        for (int ai = 0; ai < 2; ++ai)
#pragma unroll
            for (int m = 0; m < 4; ++m) { const int lr = ai * HALF + wr * 64 + m * 16 + fr;
                f32x4 o[2];
#pragma unroll
                for (int n = 0; n < 2; ++n)
#pragma unroll
                    for (int e = 0; e < 4; ++e) { const float g = acc[ai][1][m][n][e], v = acc[ai][0][m][n][e];
                        const float z = 0.7978845608028654f * (g + 0.044715f * g * g * g);
                        o[n][e] = g * __builtin_amdgcn_rcpf(1.0f + __builtin_amdgcn_exp2f(-2.0f * LOG2E * z)) * v; }
                if (lr >= 2) *(u32x4*)(act + (size_t)(u.arow + lr) * DFF + colv) = pack8(o[0], o[1]);
                asm volatile("" ::: "memory"); }
    }
};

template <class Epi, class Sched, bool ALIGN_EPI = true, bool SP2 = true>
__device__ __forceinline__ void gemm_phase(PG8_LAS unsigned char* lds, const Gemm g, const Sched& S, const Epi& E) {
    const int tid = threadIdx.x, wid = __builtin_amdgcn_readfirstlane(tid >> 6), lane = tid & 63, wr = wid >> 2, wc = wid & 3, fr = lane & 15, fq = lane >> 4;
    const int K = g.K, nt = K / BK;
    unsigned voffA[2], voffB[2];
#pragma unroll
    for (int i = 0; i < 2; ++i) { int R, C; stage_rc(tid * 16 + i * 8192, R, C); const int Rb = Epi::PERM ? ((R & ~31) + perm32(R & 31)) : R;
        voffA[i] = (unsigned)(R * K + C) * 2u; voffB[i] = (unsigned)(Rb * K + C) * 2u; }
    const size_t kstep = (size_t)(BK * 2);
    const size_t hstep = (size_t)HALF * K * 2;
    const size_t tstep = 2 * hstep;
    const long rstep = (long)K * 2;
    const unsigned ldsw = (unsigned)wid * 1024u;
    const int aoff = lds_byte(wr * 64 + fr, fq * 8), boff = lds_byte(wc * 32 + fr, fq * 8);
#define PG8_SA(b, h) (((b) * 2 + (h)) * HTB)
#define PG8_SB(b, h) ((4 + (b) * 2 + (h)) * HTB)
#define PG8_STAGE(bufoff, gbase, voff) do { _Pragma("unroll") for (int _i = 0; _i < 2; ++_i) \
        __builtin_amdgcn_global_load_lds((const unsigned*)((const char*)(gbase) + (voff)[_i]), (PG8_LAS unsigned*)(lds + (bufoff) + ldsw + _i * 8192), 16, 0, 0); } while (0)
#define PG8_LDA(dst, b, h) do { _Pragma("unroll") for (int m = 0; m < 4; ++m) _Pragma("unroll") for (int k = 0; k < 2; ++k) dst[m][k] = *(const PG8_LAS bf16x8*)(lds + PG8_SA(b, h) + aoff + m * 2048 + k * 1024); } while (0)
#define PG8_LDB(dst, b, h) do { _Pragma("unroll") for (int n = 0; n < 2; ++n) _Pragma("unroll") for (int k = 0; k < 2; ++k) dst[n][k] = *(const PG8_LAS bf16x8*)(lds + PG8_SB(b, h) + boff + n * 2048 + k * 1024); } while (0)
#define PG8_MMA(ai, bj, At, Bt) do { __builtin_amdgcn_s_setprio(1); _Pragma("unroll") for (int m = 0; m < 4; ++m) _Pragma("unroll") for (int n = 0; n < 2; ++n) _Pragma("unroll") for (int k = 0; k < 2; ++k) \
        acc[ai][bj][m][n] = __builtin_amdgcn_mfma_f32_16x16x32_bf16(Bt[n][k], At[m][k], acc[ai][bj][m][n], 0, 0, 0); __builtin_amdgcn_s_setprio(0); } while (0)
#define PG8_WAIT_V(n) asm volatile("s_waitcnt vmcnt(" #n ")" ::: "memory")
#define PG8_WAIT_L(n) asm volatile("s_waitcnt lgkmcnt(" #n ")" ::: "memory")
#define PG8_BAR __builtin_amdgcn_s_barrier()
#define PG8_SCHED __builtin_amdgcn_sched_barrier(0)
    Unit cur, nxt; int ui = 0;
    if (!S.next(0, cur)) return;
    f32x4 acc[2][2][4][2];
#pragma unroll
    for (int a = 0; a < 2; ++a)
#pragma unroll
        for (int b = 0; b < 2; ++b)
#pragma unroll
            for (int m = 0; m < 4; ++m)
#pragma unroll
                for (int n = 0; n < 2; ++n) acc[a][b][m][n] = (f32x4){0.f, 0.f, 0.f, 0.f};
    bf16x8 At[4][2], B0[2][2], B1[2][2];
    const char* cA = (const char*)g.A + (long)cur.arow * rstep; const char* cB = (const char*)g.Bt + (size_t)cur.pn * tstep;
    if constexpr (SP2) {
        PG8_STAGE(PG8_SB(0, 0), cB, voffB); PG8_STAGE(PG8_SB(0, 1), cB + hstep, voffB); PG8_STAGE(PG8_SA(0, 0), cA, voffA); PG8_STAGE(PG8_SA(0, 1), cA + hstep, voffA);
        if (wr == 1) PG8_BAR;
        PG8_WAIT_V(2); PG8_BAR;
        PG8_STAGE(PG8_SB(1, 0), cB + kstep, voffB); PG8_STAGE(PG8_SA(1, 0), cA + kstep, voffA); PG8_STAGE(PG8_SB(1, 1), cB + hstep + kstep, voffB);
        PG8_WAIT_V(6); PG8_BAR;
    } else {
        PG8_STAGE(PG8_SB(0, 0), cB, voffB); PG8_STAGE(PG8_SA(0, 0), cA, voffA); PG8_STAGE(PG8_SB(0, 1), cB + hstep, voffB); PG8_STAGE(PG8_SA(0, 1), cA + hstep, voffA);
        if (wr == 1) PG8_BAR;
        PG8_WAIT_V(4); PG8_BAR;
        PG8_STAGE(PG8_SB(1, 0), cB + kstep, voffB); PG8_STAGE(PG8_SA(1, 0), cA + kstep, voffA); PG8_STAGE(PG8_SB(1, 1), cB + hstep + kstep, voffB);
        PG8_WAIT_V(6); PG8_BAR;
    }
    for (;;) {
        const bool has_next = S.next(ui + 1, nxt);
        const char* nA = has_next ? (const char*)g.A + (long)nxt.arow * rstep : cA; const char* nB = has_next ? (const char*)g.Bt + (size_t)nxt.pn * tstep : cB;
        for (int t = 0; t < nt; t += 2) {
            const bool last = (t == nt - 2);
            const char* a1 = cA + (size_t)(t + 1) * kstep;
            const char* a2 = last ? nA : cA + (size_t)(t + 2) * kstep; const char* b2 = last ? nB : cB + (size_t)(t + 2) * kstep;
            const char* a3 = a2 + kstep; const char* b3 = b2 + kstep;
            if constexpr (SP2) {
            PG8_LDB(B0, 0, 0); PG8_LDB(B1, 0, 1); PG8_SCHED; PG8_LDA(At, 0, 0); PG8_STAGE(PG8_SA(1, 1), a1 + hstep, voffA);
            PG8_WAIT_V(8); PG8_WAIT_L(0); PG8_BAR; PG8_MMA(0, 0, At, B0); PG8_MMA(0, 1, At, B1); PG8_BAR; PG8_SCHED;
            PG8_LDA(At, 0, 1); PG8_STAGE(PG8_SB(0, 0), b2, voffB); PG8_STAGE(PG8_SB(0, 1), b2 + hstep, voffB); PG8_STAGE(PG8_SA(0, 0), a2, voffA);
            PG8_WAIT_V(8); PG8_WAIT_L(0); PG8_BAR; PG8_MMA(1, 0, At, B0); PG8_MMA(1, 1, At, B1); PG8_BAR; PG8_SCHED;
            PG8_LDB(B0, 1, 0); PG8_LDB(B1, 1, 1); PG8_SCHED; PG8_LDA(At, 1, 0); PG8_STAGE(PG8_SA(0, 1), a2 + hstep, voffA);
            PG8_WAIT_V(8); PG8_WAIT_L(0); PG8_BAR; PG8_MMA(0, 0, At, B0); PG8_MMA(0, 1, At, B1); PG8_BAR; PG8_SCHED;
            PG8_LDA(At, 1, 1); PG8_STAGE(PG8_SB(1, 0), b3, voffB); PG8_STAGE(PG8_SB(1, 1), b3 + hstep, voffB); PG8_STAGE(PG8_SA(1, 0), a3, voffA);
            PG8_WAIT_V(8); PG8_WAIT_L(0); PG8_BAR; PG8_MMA(1, 0, At, B0); PG8_MMA(1, 1, At, B1); PG8_BAR; PG8_SCHED;
            } else {
            PG8_LDB(B0, 0, 0); PG8_SCHED; PG8_LDA(At, 0, 0); PG8_STAGE(PG8_SA(1, 1), a1 + hstep, voffA);
            PG8_WAIT_L(8); PG8_BAR; PG8_WAIT_L(0); PG8_MMA(0, 0, At, B0); PG8_BAR; PG8_SCHED;
            PG8_LDB(B1, 0, 1); PG8_STAGE(PG8_SB(0, 0), b2, voffB);
            PG8_BAR; PG8_WAIT_L(0); PG8_MMA(0, 1, At, B1); PG8_BAR;
            PG8_LDA(At, 0, 1); PG8_STAGE(PG8_SA(0, 0), a2, voffA);
            PG8_BAR; PG8_WAIT_L(0); PG8_MMA(1, 0, At, B0); PG8_BAR; PG8_SCHED;
            PG8_STAGE(PG8_SB(0, 1), b2 + hstep, voffB);
            PG8_WAIT_V(6); PG8_BAR; PG8_MMA(1, 1, At, B1); PG8_BAR;
            PG8_LDB(B0, 1, 0); PG8_SCHED; PG8_LDA(At, 1, 0); PG8_STAGE(PG8_SA(0, 1), a2 + hstep, voffA);
            PG8_WAIT_L(8); PG8_BAR; PG8_WAIT_L(0); PG8_MMA(0, 0, At, B0); PG8_BAR; PG8_SCHED;
            PG8_LDB(B1, 1, 1); PG8_STAGE(PG8_SB(1, 0), b3, voffB);
            PG8_BAR; PG8_WAIT_L(0); PG8_MMA(0, 1, At, B1); PG8_BAR;
            PG8_LDA(At, 1, 1); PG8_STAGE(PG8_SA(1, 0), a3, voffA);
            PG8_BAR; PG8_WAIT_L(0); PG8_MMA(1, 0, At, B0); PG8_BAR; PG8_SCHED;
            PG8_STAGE(PG8_SB(1, 1), b3 + hstep, voffB);
            PG8_WAIT_V(6); PG8_BAR; PG8_MMA(1, 1, At, B1); PG8_BAR;
            }
        }
        if constexpr (ALIGN_EPI) { if (wr == 0) PG8_BAR; }
        E(acc, cur, wr, wc, fr, fq, lds + STAGE_BYTES);
        if (!has_next) break;
#pragma unroll
        for (int a = 0; a < 2; ++a)
#pragma unroll
            for (int b = 0; b < 2; ++b)
#pragma unroll
                for (int m = 0; m < 4; ++m)
#pragma unroll
                    for (int n = 0; n < 2; ++n) acc[a][b][m][n] = (f32x4){0.f, 0.f, 0.f, 0.f};
        cur = nxt; cA = nA; cB = nB; ++ui;
        if constexpr (ALIGN_EPI) { if (wr == 1) PG8_BAR; }
    }
    PG8_WAIT_V(0);
    if constexpr (!ALIGN_EPI) { if (wr == 0) PG8_BAR; }
    PG8_BAR;
#undef PG8_SA
#undef PG8_SB
#undef PG8_STAGE
#undef PG8_LDA
#undef PG8_LDB
#undef PG8_MMA
#undef PG8_WAIT_V
#undef PG8_WAIT_L
#undef PG8_BAR
#undef PG8_SCHED
}
}

constexpr int NWAVES = 8, NTHREADS = NWAVES * 64;
constexpr int LDS_BYTES = 147456;
#define LAS __attribute__((address_space(3)))
typedef unsigned short bf16;
typedef unsigned v4u __attribute__((ext_vector_type(4)));
typedef unsigned v2u __attribute__((ext_vector_type(2)));
typedef float f32x4 __attribute__((ext_vector_type(4)));
#define LDS_WAIT() asm volatile("s_waitcnt lgkmcnt(0)" ::: "memory")
__device__ __forceinline__ unsigned f2bf(float f) { unsigned u = __builtin_bit_cast(unsigned, f); return (u + 0x7fffu + ((u >> 16) & 1u)) >> 16; }
__device__ __forceinline__ unsigned pk2(float lo, float hi) { return f2bf(lo) | (f2bf(hi) << 16); }
__device__ __forceinline__ float bflo(unsigned w) { return __uint_as_float(w << 16); }
__device__ __forceinline__ float bfhi(unsigned w) { return __uint_as_float(w & 0xffff0000u); }
__device__ __forceinline__ float wave_sum(float v) {
#pragma unroll
    for (int o = 1; o < 64; o <<= 1) v += __shfl_xor(v, o);
    return v;
}

struct Args {
    const float* x; const int* pos; const float* g_pre; const float* w_in; const float* gate_up; const float* gate_bias; const float* g_gla; const float* sinks;
    const float* w_out; const float* g_postmix; const float* g_preffn; const float* w_up; const float* conv_w; const float* conv_b; const float* w_down; const float* g_postffn;
    float* out; unsigned char* ws; int ph_lo, ph_hi;
};

__device__ __forceinline__ void p0_transpose_item(const float* W, int ldw, int col0, int K, bf16* WT, int mode, int rowoff, const float* gain, LAS float* scr, int kb, int nb, int lane) {
    const int k0 = 64 * kb, n0 = 32 * nb;
#pragma unroll 8
    for (int i = 0; i < 32; ++i) { const int kk = 2 * i + (lane >> 5); float v = W[(size_t)(k0 + kk) * ldw + col0 + n0 + (lane & 31)]; if (gain) v *= gain[k0 + kk]; scr[kk * 33 + (lane & 31)] = v; }
    LDS_WAIT(); asm volatile("" ::: "memory");
    const int c = lane & 7;
#pragma unroll
    for (int j = 0; j < 4; ++j) { const int n = (lane >> 3) + 8 * j; const LAS float* s = scr + (8 * c) * 33 + n;
        v4u o; o.x = pk2(s[0 * 33], s[1 * 33]); o.y = pk2(s[2 * 33], s[3 * 33]); o.z = pk2(s[4 * 33], s[5 * 33]); o.w = pk2(s[6 * 33], s[7 * 33]);
        const int nn = n0 + n; int dr;
        if (mode == 0) dr = rowoff + nn;
        else dr = (nn < DFF) ? ((nn >> 7) * 256 + (nn & 127)) : (((nn - DFF) >> 7) * 256 + 128 + ((nn - DFF) & 127));
        *(v4u*)(WT + (size_t)dr * K + k0 + 8 * c) = o; }
    LDS_WAIT(); asm volatile("" ::: "memory");
}

__global__ void __launch_bounds__(NTHREADS, 2) fwd(Args a) {
    extern __shared__ __attribute__((aligned(16))) unsigned char lds_raw[];
    LAS unsigned char* lds = (LAS unsigned char*)lds_raw;
    const int tid = threadIdx.x, lane = tid & 63, wave = __builtin_amdgcn_readfirstlane(tid >> 6);
    const int G = gridDim.x, bid = blockIdx.x;
    const int gw = bid * NWAVES + wave, NGW = G * NWAVES;
    unsigned char* ws = a.ws;
    bf16* Wt_in = (bf16*)(ws + WS_WIN); bf16* Wt_out = (bf16*)(ws + WS_WOUT); bf16* Wt_up = (bf16*)(ws + WS_WUP); bf16* Wt_dn = (bf16*)(ws + WS_WDN);
    float* rope = (float*)(ws + WS_ROPE); float* rs0 = (float*)(ws + WS_RS0); float* rs1 = (float*)(ws + WS_RS1); float* part = (float*)(ws + WS_PART);
    bf16* XB = (bf16*)(ws + WS_XB); bf16* Y = (bf16*)(ws + WS_XB);
    bf16* GQ = (bf16*)(ws + WS_GQ); bf16* GK = (bf16*)(ws + WS_GK); bf16* GV = (bf16*)(ws + WS_GV); float* LA = (float*)(ws + WS_LA); bf16* GG = (bf16*)(ws + WS_GG);
    bf16* SQ = (bf16*)(ws + WS_SQ); bf16* SK = (bf16*)(ws + WS_SK); bf16* SV = (bf16*)(ws + WS_SV);
    bf16* ACT = (bf16*)(ws + WS_ACT); float* ORAW = (float*)(ws + WS_U); bf16* MIX = (bf16*)(ws + WS_MIX); bf16* X1B = (bf16*)(ws + WS_X1B);
    const int lo = a.ph_lo, hi = a.ph_hi;
#ifndef PH_MASK
#define PH_MASK 0x1ff
#endif
#define IN(k) (((PH_MASK >> (k)) & 1) && lo <= (k) && (k) < hi)
#define BOTH(k) (IN(k) && IN((k) + 1))
#if MK_ONE_LAUNCH
#define GRID_BAR() cg::this_grid().sync()
#else
#define GRID_BAR() do { } while (0)
#endif

    if (IN(0)) {
        LAS float* scr = (LAS float*)(lds + wave * 16384);
        constexpr int I_A = 16 * 32, I_B = 16 * 40, I_O = 16 * 32, I_U = 16 * 176, I_D = 44 * 32;
        constexpr int NITEMS = I_A + I_B + I_O + I_U + I_D;
        for (int it = gw; it < NITEMS; it += NGW) {
            int r = it;
            if (r < I_A) { p0_transpose_item(a.w_in, IN_W, 0, DM, Wt_in, 0, 0, a.g_pre, scr, r / 32, r % 32, lane); continue; } r -= I_A;
            if (r < I_B) { p0_transpose_item(a.w_in, IN_W, 1040, DM, Wt_in, 0, 1280, a.g_pre, scr, r / 40, r % 40, lane); continue; } r -= I_B;
            if (r < I_O) { p0_transpose_item(a.w_out, DM, 0, DM, Wt_out, 0, 0, nullptr, scr, r / 32, r % 32, lane); continue; } r -= I_O;
            if (r < I_U) { p0_transpose_item(a.w_up, NUP, 0, DM, Wt_up, 1, 0, a.g_preffn, scr, r / 176, r % 176, lane); continue; } r -= I_U;
            p0_transpose_item(a.w_down, DM, 0, DFF, Wt_dn, 0, 0, nullptr, scr, r / 32, r % 32, lane);
        }
        for (int idx = bid * NTHREADS + tid; idx < 256 * DM; idx += G * NTHREADS) { const int j = idx >> 10, k = idx & 1023;
            const float* wr_ = a.w_in + (size_t)k * IN_W + 1024; float s = 0.f;
#pragma unroll
            for (int r = 0; r < 16; ++r) s += wr_[r] * a.gate_up[r * 256 + j];
            Wt_in[(size_t)(1024 + j) * DM + k] = (bf16)f2bf(s * a.g_pre[k]); }
        for (int idx = bid * NTHREADS + tid; idx < M * 8; idx += G * NTHREADS) { const int row = idx >> 3, i = idx & 7;
            const float invf[8] = {1.0f, 0.1939227432012558f, 0.03760603070259094f, 0.007292664609849453f, 0.0014142135623842478f, 0.00027424818836152554f, 5.318296098266728e-05f, 1.0313386155758053e-05f};
            float inv = invf[0];
#pragma unroll
            for (int q = 1; q < 8; ++q) inv = (i == q) ? invf[q] : inv;
            const float ang = (float)a.pos[row] * inv;
            const double rev = (double)ang * 0.15915494309189535; const float fr_ = (float)(rev - __builtin_floor(rev));
            rope[(size_t)row * 16 + i] = __builtin_amdgcn_cosf(fr_); rope[(size_t)row * 16 + 8 + i] = __builtin_amdgcn_sinf(fr_); }
        for (int m = gw; m < M; m += NGW) { const f32x4* xr = (const f32x4*)(a.x + (size_t)m * DM) + lane; f32x4 v[4]; float s = 0.f;
#pragma unroll
            for (int j = 0; j < 4; ++j) { v[j] = xr[64 * j]; s += (v[j].x * v[j].x + v[j].y * v[j].y) + (v[j].z * v[j].z + v[j].w * v[j].w); }
            s = wave_sum(s); if (lane == 0) rs0[m] = 1.0f / sqrtf(s * (1.0f / DM) + EPS);
            v2u* o8 = (v2u*)(XB + (size_t)m * DM) + lane;
#pragma unroll
            for (int j = 0; j < 4; ++j) { v2u w; w.x = pk2(v[j].x, v[j].y); w.y = pk2(v[j].z, v[j].w); o8[64 * j] = w; } }
        if (BOTH(0)) GRID_BAR();
    }

    if (IN(1)) {
        pg8::Gemm g{XB, Wt_in, DM}; pg8::StaticOrder S; S.init(M, NIN, G, bid);
        pg8::EpiIn E{rs0, rope, a.gate_bias, GQ, GK, GV, GG, SQ, SK, SV, LA};
        pg8::gemm_phase<pg8::EpiIn, pg8::StaticOrder>(lds, g, S, E);
        if (BOTH(1)) GRID_BAR();
    }

    if (IN(2)) {
        const bool split = G >= 64;
        {
            LAS float* qs = (LAS float*)lds; LAS float* ks = qs + 4096; LAS float* as = ks + 4096; LAS float* vs = as + 4096;
            const int j = 16 * wave + (lane & 15), kq = lane >> 4;
            for (int unit = bid; unit < 32; unit += G) { const int b = unit >> 2, h = unit & 3;
                float S[16];
#pragma unroll
                for (int d = 0; d < 16; ++d) S[d] = 0.f;
                for (int blk = 0; blk < SEQ / 64; ++blk) { const size_t row0 = (size_t)b * SEQ + blk * 64;
                    __syncthreads();
                    { const int r = tid >> 3, c8 = (tid & 7) * 8;
                      const v4u qv = *(const v4u*)(GQ + (row0 + r) * 256 + h * 64 + c8), kv = *(const v4u*)(GK + (row0 + r) * 256 + h * 64 + c8);
                      const f32x4 l0 = *(const f32x4*)(LA + (row0 + r) * 256 + h * 64 + c8), l1 = *(const f32x4*)(LA + (row0 + r) * 256 + h * 64 + c8 + 4);
                      LAS float* qd = qs + r * 64 + c8; LAS float* kd = ks + r * 64 + c8; LAS float* ad = as + r * 64 + c8;
                      qd[0] = bflo(qv.x); qd[1] = bfhi(qv.x); qd[2] = bflo(qv.y); qd[3] = bfhi(qv.y); qd[4] = bflo(qv.z); qd[5] = bfhi(qv.z); qd[6] = bflo(qv.w); qd[7] = bfhi(qv.w);
                      kd[0] = bflo(kv.x); kd[1] = bfhi(kv.x); kd[2] = bflo(kv.y); kd[3] = bfhi(kv.y); kd[4] = bflo(kv.z); kd[5] = bfhi(kv.z); kd[6] = bflo(kv.w); kd[7] = bfhi(kv.w);
#pragma unroll
                      for (int e = 0; e < 4; ++e) { ad[e] = __builtin_amdgcn_exp2f(l0[e] * LOG2E); ad[4 + e] = __builtin_amdgcn_exp2f(l1[e] * LOG2E); }
                      const int rv = tid >> 3, cv = (tid & 7) * 16;
                      const v4u v0 = *(const v4u*)(GV + (row0 + rv) * 512 + h * 128 + cv), v1 = *(const v4u*)(GV + (row0 + rv) * 512 + h * 128 + cv + 8);
                      LAS float* vd = vs + rv * 128 + cv;
                      vd[0] = bflo(v0.x); vd[1] = bfhi(v0.x); vd[2] = bflo(v0.y); vd[3] = bfhi(v0.y); vd[4] = bflo(v0.z); vd[5] = bfhi(v0.z); vd[6] = bflo(v0.w); vd[7] = bfhi(v0.w);
                      vd[8] = bflo(v1.x); vd[9] = bfhi(v1.x); vd[10] = bflo(v1.y); vd[11] = bfhi(v1.y); vd[12] = bflo(v1.z); vd[13] = bfhi(v1.z); vd[14] = bflo(v1.w); vd[15] = bfhi(v1.w); }
                    __syncthreads();
                    for (int t = 0; t < 64; ++t) { const float vt = vs[t * 128 + j]; float o = 0.f;
#pragma unroll
                        for (int d4 = 0; d4 < 4; ++d4) { const f32x4 a4 = *(const LAS f32x4*)(as + t * 64 + 16 * kq + 4 * d4), k4 = *(const LAS f32x4*)(ks + t * 64 + 16 * kq + 4 * d4), q4 = *(const LAS f32x4*)(qs + t * 64 + 16 * kq + 4 * d4);
#pragma unroll
                            for (int e = 0; e < 4; ++e) { S[4 * d4 + e] = a4[e] * S[4 * d4 + e] + k4[e] * vt; o += q4[e] * S[4 * d4 + e]; } }
                        o += __shfl_xor(o, 16); o += __shfl_xor(o, 32);
                        if (kq == 0) ORAW[(row0 + t) * 512 + h * 128 + j] = o; }
                }
            }
        }
        if (!split || bid >= 32) {
            const int sb = split ? bid - 32 : bid, sg = split ? G - 32 : G;
            const int hh = wave, kvh = hh >> 2;
            const float sink2 = a.sinks[hh] * LOG2E;
            for (int unit = sb; unit < M / 64; unit += sg) { const size_t row = (size_t)unit * 64 + lane; const int b = (unit * 64) / SEQ, tw0 = (unit * 64) % SEQ, t = tw0 + lane;
                float q[64], o[64];
#pragma unroll
                for (int c = 0; c < 8; ++c) { const v4u w = *(const v4u*)(SQ + row * 512 + hh * 64 + c * 8);
                    q[8 * c] = bflo(w.x); q[8 * c + 1] = bfhi(w.x); q[8 * c + 2] = bflo(w.y); q[8 * c + 3] = bfhi(w.y); q[8 * c + 4] = bflo(w.z); q[8 * c + 5] = bfhi(w.z); q[8 * c + 6] = bflo(w.w); q[8 * c + 7] = bfhi(w.w); }
#pragma unroll
                for (int d = 0; d < 64; ++d) o[d] = 0.f;
                float mx = sink2, l = 1.0f;
                const int jlo = tw0 - 127 < 0 ? 0 : tw0 - 127, jhi = tw0 + 63;
                for (int jj = jlo; jj <= jhi; ++jj) { const size_t krow = (size_t)b * SEQ + jj; const bf16* kp = SK + krow * 128 + kvh * 64; const bf16* vp = SV + krow * 128 + kvh * 64;
                    float s = 0.f;
#pragma unroll
                    for (int c = 0; c < 8; ++c) { const v4u w = *(const v4u*)(kp + c * 8);
                        s += q[8 * c] * bflo(w.x) + q[8 * c + 1] * bfhi(w.x) + q[8 * c + 2] * bflo(w.y) + q[8 * c + 3] * bfhi(w.y) + q[8 * c + 4] * bflo(w.z) + q[8 * c + 5] * bfhi(w.z) + q[8 * c + 6] * bflo(w.w) + q[8 * c + 7] * bfhi(w.w); }
                    const bool valid = (jj <= t) && (jj > t - 128);
                    const float mn = valid ? __builtin_fmaxf(mx, s) : mx;
                    const float al = __builtin_amdgcn_exp2f(mx - mn), p = valid ? __builtin_amdgcn_exp2f(s - mn) : 0.f;
                    l = l * al + p; mx = mn;
#pragma unroll
                    for (int c = 0; c < 8; ++c) { const v4u w = *(const v4u*)(vp + c * 8);
                        o[8 * c] = o[8 * c] * al + p * bflo(w.x); o[8 * c + 1] = o[8 * c + 1] * al + p * bfhi(w.x); o[8 * c + 2] = o[8 * c + 2] * al + p * bflo(w.y); o[8 * c + 3] = o[8 * c + 3] * al + p * bfhi(w.y);
                        o[8 * c + 4] = o[8 * c + 4] * al + p * bflo(w.z); o[8 * c + 5] = o[8 * c + 5] * al + p * bfhi(w.z); o[8 * c + 6] = o[8 * c + 6] * al + p * bflo(w.w); o[8 * c + 7] = o[8 * c + 7] * al + p * bfhi(w.w); }
                }
                const float rl = 1.0f / l;
#pragma unroll
                for (int c = 0; c < 8; ++c) { v4u w; w.x = pk2(o[8 * c] * rl, o[8 * c + 1] * rl); w.y = pk2(o[8 * c + 2] * rl, o[8 * c + 3] * rl); w.z = pk2(o[8 * c + 4] * rl, o[8 * c + 5] * rl); w.w = pk2(o[8 * c + 6] * rl, o[8 * c + 7] * rl);
                    *(v4u*)(MIX + row * DM + 512 + hh * 64 + c * 8) = w; }
            }
        }
        __syncthreads();
        if (BOTH(2)) GRID_BAR();
    }

    if (IN(3)) {
        for (int m = gw; m < M; m += NGW) { const float* orow = ORAW + (size_t)m * 512 + 8 * lane; const f32x4 o0 = *(const f32x4*)orow, o1 = *(const f32x4*)(orow + 4);
            float s = (o0.x * o0.x + o0.y * o0.y) + (o0.z * o0.z + o0.w * o0.w) + (o1.x * o1.x + o1.y * o1.y) + (o1.z * o1.z + o1.w * o1.w);
            s += __shfl_xor(s, 1); s += __shfl_xor(s, 2); s += __shfl_xor(s, 4); s += __shfl_xor(s, 8);
            const float rs = 1.0f / sqrtf(s * (1.0f / 128.0f) + EPS);
            const int dv = (8 * lane) & 127; const f32x4 w0 = *(const f32x4*)(a.g_gla + dv), w1 = *(const f32x4*)(a.g_gla + dv + 4);
            const v4u gw_ = *(const v4u*)(GG + (size_t)m * 512 + 8 * lane);
            v4u w; w.x = pk2(o0.x * rs * w0.x * bflo(gw_.x), o0.y * rs * w0.y * bfhi(gw_.x)); w.y = pk2(o0.z * rs * w0.z * bflo(gw_.y), o0.w * rs * w0.w * bfhi(gw_.y));
            w.z = pk2(o1.x * rs * w1.x * bflo(gw_.z), o1.y * rs * w1.y * bfhi(gw_.z)); w.w = pk2(o1.z * rs * w1.z * bflo(gw_.w), o1.w * rs * w1.w * bfhi(gw_.w));
            *(v4u*)(MIX + (size_t)m * DM + 8 * lane) = w; }
        if (BOTH(3)) GRID_BAR();
    }

    if (IN(4)) {
        pg8::Gemm g{MIX, Wt_out, DM}; pg8::StaticOrder S; S.init(M, DM, G, bid);
        pg8::EpiY E{Y, part};
        pg8::gemm_phase<pg8::EpiY, pg8::StaticOrder>(lds, g, S, E);
        if (BOTH(4)) GRID_BAR();
    }

    if (IN(5)) {
        for (int m = gw; m < M; m += NGW) {
            float p = (lane < 16) ? part[(size_t)m * 16 + lane] : 0.f; p = wave_sum(p);
            const float rs = 1.0f / sqrtf(p * (1.0f / DM) + EPS);
            const f32x4* xr = (const f32x4*)(a.x + (size_t)m * DM) + lane; const v2u* yr = (const v2u*)(Y + (size_t)m * DM) + lane; const f32x4* gr = (const f32x4*)a.g_postmix + lane;
            f32x4* orow = (f32x4*)(a.out + (size_t)m * DM) + lane; v2u* xb = (v2u*)(X1B + (size_t)m * DM) + lane; float s = 0.f;
#pragma unroll
            for (int j = 0; j < 4; ++j) { const f32x4 xv = xr[64 * j], gv = gr[64 * j]; const v2u yw = yr[64 * j];
                f32x4 r; r.x = xv.x + bflo(yw.x) * rs * gv.x; r.y = xv.y + bfhi(yw.x) * rs * gv.y; r.z = xv.z + bflo(yw.y) * rs * gv.z; r.w = xv.w + bfhi(yw.y) * rs * gv.w;
                s += (r.x * r.x + r.y * r.y) + (r.z * r.z + r.w * r.w);
                orow[64 * j] = r; v2u w; w.x = pk2(r.x, r.y); w.y = pk2(r.z, r.w); xb[64 * j] = w; }
            s = wave_sum(s); if (lane == 0) rs1[m] = 1.0f / sqrtf(s * (1.0f / DM) + EPS); }
        if (BOTH(5)) GRID_BAR();
    }

    if (IN(6)) {
        pg8::Gemm g{X1B, Wt_up, DM}; pg8::UpOrder S{G, bid};
        pg8::EpiUp E{ACT, rs1, a.conv_w, a.conv_b};
        pg8::gemm_phase<pg8::EpiUp, pg8::UpOrder>(lds, g, S, E);
        if (BOTH(6)) GRID_BAR();
    }

    if (IN(7)) {
        pg8::Gemm g{ACT, Wt_dn, DFF}; pg8::StaticOrder S; S.init(M, DM, G, bid);
        pg8::EpiY E{Y, part};
        pg8::gemm_phase<pg8::EpiY, pg8::StaticOrder>(lds, g, S, E);
        if (BOTH(7)) GRID_BAR();
    }

    if (IN(8)) {
        for (int m = gw; m < M; m += NGW) {
            float p = (lane < 16) ? part[(size_t)m * 16 + lane] : 0.f; p = wave_sum(p);
            const float rs = 1.0f / sqrtf(p * (1.0f / DM) + EPS);
            const v2u* yr = (const v2u*)(Y + (size_t)m * DM) + lane; const f32x4* gr = (const f32x4*)a.g_postffn + lane; f32x4* orow = (f32x4*)(a.out + (size_t)m * DM) + lane;
#pragma unroll
            for (int j = 0; j < 4; ++j) { const f32x4 xv = orow[64 * j], gv = gr[64 * j]; const v2u yw = yr[64 * j];
                f32x4 r; r.x = xv.x + bflo(yw.x) * rs * gv.x; r.y = xv.y + bfhi(yw.x) * rs * gv.y; r.z = xv.z + bflo(yw.y) * rs * gv.z; r.w = xv.w + bfhi(yw.y) * rs * gv.w;
                orow[64 * j] = r; } }
    }
#undef IN
#undef BOTH
}

constexpr int N_PHASES = 9;

extern "C" void kernel_launch(void* const* d_in, const int* in_sizes, int n_in, void* d_out, int out_size, void* d_ws, size_t ws_size, hipStream_t stream) {
    static int grid = 0;
    if (grid == 0) {
        if (n_in != 16 || in_sizes[0] != M * DM || out_size != M * DM || ws_size < WS_END) { fprintf(stderr, "kernel_launch: unexpected shapes (n_in %d, in0 %d, out %d, ws %zu); nothing launched\n", n_in, n_in > 0 ? in_sizes[0] : -1, out_size, ws_size); grid = -1; return; }
        int dev = 0, cus = 0, per_cu = 0;
        if (hipGetDevice(&dev) != hipSuccess || hipDeviceGetAttribute(&cus, hipDeviceAttributeMultiprocessorCount, dev) != hipSuccess) { grid = -1; return; }
        if (hipFuncSetAttribute((const void*)fwd, hipFuncAttributeMaxDynamicSharedMemorySize, LDS_BYTES) != hipSuccess) { fprintf(stderr, "kernel_launch: hipFuncSetAttribute failed\n"); grid = -1; return; }
        if (hipOccupancyMaxActiveBlocksPerMultiprocessor(&per_cu, (const void*)fwd, NTHREADS, LDS_BYTES) != hipSuccess || per_cu < 1) { fprintf(stderr, "kernel_launch: occupancy query says %d\n", per_cu); per_cu = 1; }
        (void)hipGetLastError();
        grid = cus * (per_cu < 1 ? 1 : per_cu);
        if (grid > cus) grid = cus;
    }
    if (grid < 0) return;
    (void)hipMemsetAsync((char*)d_ws + WS_CTL, 0, CTL_ZERO_BYTES, stream);
    Args a{};
    a.x = (const float*)d_in[0]; a.pos = (const int*)d_in[1]; a.g_pre = (const float*)d_in[2]; a.w_in = (const float*)d_in[3]; a.gate_up = (const float*)d_in[4]; a.gate_bias = (const float*)d_in[5];
    a.g_gla = (const float*)d_in[6]; a.sinks = (const float*)d_in[7]; a.w_out = (const float*)d_in[8]; a.g_postmix = (const float*)d_in[9]; a.g_preffn = (const float*)d_in[10]; a.w_up = (const float*)d_in[11];
    a.conv_w = (const float*)d_in[12]; a.conv_b = (const float*)d_in[13]; a.w_down = (const float*)d_in[14]; a.g_postffn = (const float*)d_in[15];
    a.out = (float*)d_out; a.ws = (unsigned char*)d_ws;
#if MK_ONE_LAUNCH
    a.ph_lo = 0; a.ph_hi = N_PHASES;
    void* args[] = {&a};
    hipError_t e = hipLaunchCooperativeKernel((const void*)fwd, dim3(grid), dim3(NTHREADS), args, LDS_BYTES, stream);
    if (e != hipSuccess) fprintf(stderr, "kernel_launch: cooperative launch failed: %s (grid %d)\n", hipGetErrorString(e), grid);
#else
    for (int p = 0; p < N_PHASES; ++p) { a.ph_lo = p; a.ph_hi = p + 1; hipLaunchKernelGGL(fwd, dim3(grid), dim3(NTHREADS), LDS_BYTES, stream, a); }
#endif
}
```

```cpp
#include <hip/hip_runtime.h>
#include <hip/hip_cooperative_groups.h>
#include <cstdio>
#include <cstdint>
namespace cg = cooperative_groups;

#ifndef MK_ONE_LAUNCH
#define MK_ONE_LAUNCH 1
#endif

constexpr int BATCH = 8, SEQ = 8192, DM = 1024, M = BATCH * SEQ;
constexpr int IN_W = 2320, NIN = 2560;
constexpr int DFF = 2816, NUP = 2 * DFF;
constexpr float EPS = 1e-6f;
constexpr float LOG2E = 1.4426950408889634f;
constexpr float QSCALE = 0.125f * LOG2E;
constexpr int UP_TILE = 254, UP_MT = 33, UP_NT = 22, UP_UNITS = BATCH * UP_MT * UP_NT;

constexpr size_t MiB = 1u << 20;
constexpr size_t WS_CTL = 0, CTL_ZERO_BYTES = 1 * MiB;
constexpr size_t WS_WIN = 2 * MiB, WS_WOUT = 7 * MiB, WS_WUP = 9 * MiB, WS_WDN = 20 * MiB;
constexpr size_t WS_GDEC = 35 * MiB;
constexpr size_t WS_ROPE = 26 * MiB, WS_RS0 = 30 * MiB, WS_RS1 = 30 * MiB + 512 * 1024, WS_PART = 31 * MiB;
constexpr size_t WS_XB = 64 * MiB;
constexpr size_t WS_GQ = 192 * MiB, WS_GK = 224 * MiB, WS_GV = 256 * MiB, WS_LA = 320 * MiB, WS_GG = 384 * MiB, WS_SQ = 448 * MiB, WS_SK = 512 * MiB, WS_SV = 528 * MiB;
constexpr size_t WS_ACT = 192 * MiB;
constexpr size_t WS_U = 544 * MiB;
constexpr size_t WS_S = 672 * MiB;
constexpr size_t WS_MIX = 736 * MiB;
constexpr size_t WS_X1B = 864 * MiB;
constexpr size_t WS_END = 1024 * MiB;

namespace pg8 {
#define PG8_LAS __attribute__((address_space(3)))
typedef unsigned short bf16_t;
typedef short bf16x8 __attribute__((ext_vector_type(8)));
typedef float f32x4 __attribute__((ext_vector_type(4)));
typedef unsigned u32x4 __attribute__((ext_vector_type(4)));
constexpr int BM = 256, BK = 64, HALF = 128, HTB = HALF * BK * 2, STAGE_BYTES = 8 * HTB, NXCD = 8, WGM = 8;

__host__ __device__ __forceinline__ int lds_byte(int r, int c) { const int st = (r >> 4) * 2 + (c >> 5), rr = r & 15, cc = c & 31, ob = rr * 64 + cc * 2; return st * 1024 + (ob ^ (((ob >> 9) & 1) << 5)); }
__host__ __device__ __forceinline__ void stage_rc(int b, int& R, int& C) { const int st = b / 1024, sb = b % 1024, swz = sb ^ (((sb >> 9) & 1) << 5); R = (st >> 1) * 16 + swz / 64; C = (st & 1) * 32 + (swz % 64) / 2; }
__host__ __device__ __forceinline__ int perm32(int rho) { const int n = rho >> 4, i = rho & 15; return 8 * (i >> 2) + 4 * n + (i & 3); }

struct Unit { int pm, pn, arow, aux; };
struct Gemm { const bf16_t* A; const bf16_t* Bt; int K; };

struct StaticOrder {
    int nM, nN, nwg, G, c;
    __device__ void init(int M_, int N_, int G_, int c_) { nM = M_ / BM; nN = N_ / BM; nwg = nM * nN; G = G_; c = c_; }
    __device__ bool next(int i, Unit& u) const {
        const long L = (long)i * G + c; if (L >= nwg) return false;
        int wgid = (int)L; { const int q = nwg / NXCD, r = nwg % NXCD, xcd = wgid % NXCD, off = wgid / NXCD; wgid = (xcd < r ? xcd * (q + 1) : r * (q + 1) + (xcd - r) * q) + off; }
        const int nig = WGM * nN, gid = wgid / nig, fm = gid * WGM, gsz = (nM - fm) < WGM ? (nM - fm) : WGM;
        u.pm = fm + ((wgid % nig) % gsz); u.pn = (wgid % nig) / gsz; u.arow = u.pm * BM; u.aux = 0; return true;
    }
};
struct UpOrder {
    int G, c;
    __device__ bool next(int i, Unit& u) const {
        const long L = (long)i * G + c; if (L >= UP_UNITS) return false;
        const int seq = (int)(L % 8), off = (int)(L / 8);
        const int nig = WGM * UP_NT, gid = off / nig, fm = gid * WGM, gsz = (UP_MT - fm) < WGM ? (UP_MT - fm) : WGM, rem = off % nig;
        u.pm = fm + rem % gsz; u.pn = rem / gsz;
        int t0 = u.pm * UP_TILE; if (t0 > SEQ - UP_TILE) t0 = SEQ - UP_TILE;
        u.arow = seq * SEQ + t0 - 2; u.aux = t0 - 2; return true;
    }
};

__device__ __forceinline__ unsigned cvt_pk_bf16(float lo, float hi) { unsigned r; asm volatile("v_cvt_pk_bf16_f32 %0, %1, %2" : "=v"(r) : "v"(lo), "v"(hi)); return r; }
__device__ __forceinline__ u32x4 pack8(const f32x4& v0, const f32x4& v1) { u32x4 w; w.x = cvt_pk_bf16(v0[0], v0[1]); w.y = cvt_pk_bf16(v0[2], v0[3]); w.z = cvt_pk_bf16(v1[0], v1[1]); w.w = cvt_pk_bf16(v1[2], v1[3]); return w; }
__device__ __forceinline__ float sigmoidf_(float v) { return __builtin_amdgcn_rcpf(1.0f + __builtin_amdgcn_exp2f(-v * LOG2E)); }
__device__ __forceinline__ float shx(float v, int m) { return __shfl_xor(v, m); }


struct EpiIn {
    static constexpr bool PERM = true;
    const float* rs0; const float* rope; const float* gbias;
    bf16_t *gq, *gk, *gv, *gg, *sq, *sk, *sv; float* la;
    __device__ __forceinline__ void operator()(f32x4 (&acc)[2][2][4][2], const Unit& u, int wr, int wc, int fr, int fq, PG8_LAS unsigned char*) const {
        asm volatile("" : "+v"(fr), "+v"(fq));
        const int pn = u.pn, cw = 32 * wc + 8 * fq, row0 = u.arow + wr * 64 + fr;
        if (pn == 4) {
            f32x4 bv[2][2];
#pragma unroll
            for (int bj = 0; bj < 2; ++bj)
#pragma unroll
                for (int n = 0; n < 2; ++n) bv[bj][n] = *(const f32x4*)(gbias + bj * HALF + cw + 4 * n);
#pragma unroll
            for (int ai = 0; ai < 2; ++ai)
#pragma unroll
                for (int m = 0; m < 4; ++m) { const int row = row0 + ai * HALF + m * 16; const float s = rs0[row];
#pragma unroll
                    for (int bj = 0; bj < 2; ++bj)
#pragma unroll
                        for (int n = 0; n < 2; ++n) { f32x4 v = acc[ai][bj][m][n] * s + bv[bj][n], o;
#pragma unroll
                            for (int e = 0; e < 4; ++e) { const float x = v[e], ex = __builtin_amdgcn_exp2f(-__builtin_fabsf(x) * LOG2E);
                                o[e] = (__builtin_fminf(x, 0.f) - __builtin_amdgcn_logf(1.0f + ex) * 0.6931471805599453f) * (1.0f / 16.0f); }
                            *(f32x4*)(la + (size_t)row * 256 + bj * HALF + cw + 4 * n) = o; } }
            return;
        }
        bf16_t* dst0; bf16_t* dst1; int ld; float sc = 1.f; bool rot0 = false, rot1 = false, silu = false;
        if (pn == 0) { dst0 = gq; dst1 = gq + HALF; ld = 256; sc = 0.125f; }
        else if (pn == 1) { dst0 = gk; dst1 = gk + HALF; ld = 256; }
        else if (pn <= 3) { dst0 = gv + (pn - 2) * 256; dst1 = dst0 + HALF; ld = 512; }
        else if (pn <= 6) { dst0 = gg + (pn - 5) * 256; dst1 = dst0 + HALF; ld = 512; silu = true; }
        else if (pn <= 8) { dst0 = sq + (pn - 7) * 256; dst1 = dst0 + HALF; ld = 512; rot0 = rot1 = true; sc = QSCALE; }
        else { dst0 = sk; dst1 = sv; ld = 128; rot0 = true; }
        const bool rw = (wc & 1) == 0;
        const float sgn = (fq == 0) ? -1.f : 1.f;
#pragma unroll
        for (int ai = 0; ai < 2; ++ai)
#pragma unroll
            for (int m = 0; m < 4; ++m) { const int row = row0 + ai * HALF + m * 16; const float s = rs0[row];
                f32x4 c0, c1, s0, s1;
                if (rot0 && rw) { const float* rp = rope + (size_t)row * 16; c0 = *(const f32x4*)(rp); c1 = *(const f32x4*)(rp + 4); s0 = *(const f32x4*)(rp + 8); s1 = *(const f32x4*)(rp + 12); }
#pragma unroll
                for (int bj = 0; bj < 2; ++bj) { f32x4 v0 = acc[ai][bj][m][0] * s, v1 = acc[ai][bj][m][1] * s;
                    if (silu) {
#pragma unroll
                        for (int e = 0; e < 4; ++e) { v0[e] = v0[e] * sigmoidf_(v0[e]); v1[e] = v1[e] * sigmoidf_(v1[e]); } }
                    if ((bj == 0 ? rot0 : rot1) && rw) { f32x4 p0, p1;
#pragma unroll
                        for (int e = 0; e < 4; ++e) { p0[e] = shx(v0[e], 16); p1[e] = shx(v1[e], 16); }
                        if (fq < 2) { v0 = v0 * c0 + (p0 * s0) * sgn; v1 = v1 * c1 + (p1 * s1) * sgn; } }
                    v0 = v0 * sc; v1 = v1 * sc;
                    *(u32x4*)((bj == 0 ? dst0 : dst1) + (size_t)row * ld + cw) = pack8(v0, v1); } }
    }
};

struct EpiY {
    static constexpr bool PERM = true;
    bf16_t* y; float* part;
    __device__ __forceinline__ void operator()(f32x4 (&acc)[2][2][4][2], const Unit& u, int wr, int wc, int fr, int fq, PG8_LAS unsigned char*) const {
        asm volatile("" : "+v"(fr), "+v"(fq));
        const int row0 = u.arow + wr * 64 + fr, col0 = u.pn * BM + wc * 32 + 8 * fq;
#pragma unroll
        for (int ai = 0; ai < 2; ++ai)
#pragma unroll
            for (int m = 0; m < 4; ++m) { const int row = row0 + ai * HALF + m * 16; float ss = 0.f;
#pragma unroll
                for (int bj = 0; bj < 2; ++bj) { const f32x4 v0 = acc[ai][bj][m][0], v1 = acc[ai][bj][m][1];
                    ss += (v0[0] * v0[0] + v0[1] * v0[1]) + (v0[2] * v0[2] + v0[3] * v0[3]) + (v1[0] * v1[0] + v1[1] * v1[1]) + (v1[2] * v1[2] + v1[3] * v1[3]);
                    *(u32x4*)(y + (size_t)row * DM + col0 + bj * HALF) = pack8(v0, v1); }
                ss += shx(ss, 16); ss += shx(ss, 32);
                if (fq == 0) part[(size_t)row * 16 + u.pn * 4 + wc] = ss; }
    }
};

struct EpiUp {
    static constexpr bool PERM = true;
    bf16_t* act; const float* rs1; const float* cw; const float* cb;
    __device__ __forceinline__ void operator()(f32x4 (&acc)[2][2][4][2], const Unit& u, int wr, int wc, int fr, int fq, PG8_LAS unsigned char* xl) const {
        asm volatile("" : "+v"(fr), "+v"(fq));
#pragma unroll
        for (int ai = 0; ai < 2; ++ai)
#pragma unroll
            for (int m = 0; m < 4; ++m) { const float s = rs1[u.arow + ai * HALF + wr * 64 + m * 16 + fr];
#pragma unroll
                for (int bj = 0; bj < 2; ++bj)
#pragma unroll
                    for (int n = 0; n < 2; ++n) acc[ai][bj][m][n] = acc[ai][bj][m][n] * s; }
        asm volatile("" ::: "memory");
        PG8_LAS f32x4* X = (PG8_LAS f32x4*)xl;
        if (fr >= 14) {
#pragma unroll
            for (int ai = 0; ai < 2; ++ai)
#pragma unroll
                for (int bj = 0; bj < 2; ++bj)
#pragma unroll
                    for (int n = 0; n < 2; ++n) X[((((ai * 2 + wr) * 4 + wc) * 2 + (fr - 14)) * 4 + fq) * 4 + bj * 2 + n] = acc[ai][bj][3][n];
        }
        asm volatile("s_waitcnt lgkmcnt(0)" ::: "memory"); __builtin_amdgcn_s_barrier(); asm volatile("" ::: "memory");
#define DPPF(v, ctrl) __int_as_float(__builtin_amdgcn_update_dpp(0, __float_as_int(v), (ctrl), 0xf, 0xf, true))
        const int colv = u.pn * HALF + wc * 32 + 8 * fq;
        const f32x4 zero4 = (f32x4){0.f, 0.f, 0.f, 0.f};
#pragma unroll
        for (int bj = 0; bj < 2; ++bj) {
#pragma unroll
            for (int n = 0; n < 2; ++n) { const int c = bj * DFF + colv + 4 * n;
                const f32x4 pb = *(const f32x4*)(cb + c), p0 = *(const f32x4*)(cw + c), p1 = *(const f32x4*)(cw + NUP + c), p2 = *(const f32x4*)(cw + 2 * NUP + c);
#pragma unroll
                for (int ai = 0; ai < 2; ++ai) {
                    const bool has = !(wr == 0 && ai == 0);
                    const int pai = (wr == 1) ? ai : ai - 1, pwr = (wr == 1) ? 0 : 1;
                    f32x4 prev = zero4;
                    if (has && fr >= 14) prev = X[((((pai * 2 + pwr) * 4 + wc) * 2 + (fr - 14)) * 4 + fq) * 4 + bj * 2 + n];
#pragma unroll
                    for (int m = 0; m < 4; ++m) {
                        const f32x4 cur = acc[ai][bj][m][n]; f32x4 q1, q2;
#pragma unroll
                        for (int e = 0; e < 4; ++e) { q1[e] = DPPF(cur[e], 0x111) + DPPF(prev[e], 0x10F); q2[e] = DPPF(cur[e], 0x112) + DPPF(prev[e], 0x10E); }
                        const int t = u.aux + ai * HALF + wr * 64 + m * 16 + fr;
                        if (t < 1) q1 = zero4;
                        if (t < 2) q2 = zero4;
                        acc[ai][bj][m][n] = pb + p0 * q2 + p1 * q1 + p2 * cur;
                        asm volatile("" : "+v"(acc[ai][bj][m][n]));
                        prev = cur;
                    }
                    asm volatile("" ::: "memory");
                }
            }
        }
#undef DPPF
#pragma unroll
        for (int ai = 0; ai < 2; ++ai)
#pragma unroll
            for (int m = 0; m < 4; ++m) { const int lr = ai * HALF + wr * 64 + m * 16 + fr;
                f32x4 o[2];
#pragma unroll
                for (int n = 0; n < 2; ++n)
#pragma unroll
                    for (int e = 0; e < 4; ++e) { const float g = acc[ai][1][m][n][e], v = acc[ai][0][m][n][e];
                        const float z = 0.7978845608028654f * (g + 0.044715f * g * g * g);
                        o[n][e] = g * __builtin_amdgcn_rcpf(1.0f + __builtin_amdgcn_exp2f(-2.0f * LOG2E * z)) * v; }
                if (lr >= 2) *(u32x4*)(act + (size_t)(u.arow + lr) * DFF + colv) = pack8(o[0], o[1]);
                asm volatile("" ::: "memory"); }
    }
};

template <class Epi, class Sched, bool ALIGN_EPI = true, bool SP2 = true>
__device__ __forceinline__ void gemm_phase(PG8_LAS unsigned char* lds, const Gemm g, const Sched& S, const Epi& E) {
    const int tid = threadIdx.x, wid = __builtin_amdgcn_readfirstlane(tid >> 6), lane = tid & 63, wr = wid >> 2, wc = wid & 3, fr = lane & 15, fq = lane >> 4;
    const int K = g.K, nt = K / BK;
    unsigned voffA[2], voffB[2];
#pragma unroll
    for (int i = 0; i < 2; ++i) { int R, C; stage_rc(tid * 16 + i * 8192, R, C); const int Rb = Epi::PERM ? ((R & ~31) + perm32(R & 31)) : R;
        voffA[i] = (unsigned)(R * K + C) * 2u; voffB[i] = (unsigned)(Rb * K + C) * 2u; }
    const size_t kstep = (size_t)(BK * 2);
    const size_t hstep = (size_t)HALF * K * 2;
    const size_t tstep = 2 * hstep;
    const long rstep = (long)K * 2;
    const unsigned ldsw = (unsigned)wid * 1024u;
    const int aoff = lds_byte(wr * 64 + fr, fq * 8), boff = lds_byte(wc * 32 + fr, fq * 8);
#define PG8_SA(b, h) (((b) * 2 + (h)) * HTB)
#define PG8_SB(b, h) ((4 + (b) * 2 + (h)) * HTB)
#define PG8_STAGE(bufoff, gbase, voff) do { _Pragma("unroll") for (int _i = 0; _i < 2; ++_i) \
        __builtin_amdgcn_global_load_lds((const unsigned*)((const char*)(gbase) + (voff)[_i]), (PG8_LAS unsigned*)(lds + (bufoff) + ldsw + _i * 8192), 16, 0, 0); } while (0)
#define PG8_LDA(dst, b, h) do { _Pragma("unroll") for (int m = 0; m < 4; ++m) _Pragma("unroll") for (int k = 0; k < 2; ++k) dst[m][k] = *(const PG8_LAS bf16x8*)(lds + PG8_SA(b, h) + aoff + m * 2048 + k * 1024); } while (0)
#define PG8_LDB(dst, b, h) do { _Pragma("unroll") for (int n = 0; n < 2; ++n) _Pragma("unroll") for (int k = 0; k < 2; ++k) dst[n][k] = *(const PG8_LAS bf16x8*)(lds + PG8_SB(b, h) + boff + n * 2048 + k * 1024); } while (0)
#define PG8_MMA(ai, bj, At, Bt) do { __builtin_amdgcn_s_setprio(1); _Pragma("unroll") for (int m = 0; m < 4; ++m) _Pragma("unroll") for (int n = 0; n < 2; ++n) _Pragma("unroll") for (int k = 0; k < 2; ++k) \
        acc[ai][bj][m][n] = __builtin_amdgcn_mfma_f32_16x16x32_bf16(Bt[n][k], At[m][k], acc[ai][bj][m][n], 0, 0, 0); __builtin_amdgcn_s_setprio(0); } while (0)
#define PG8_WAIT_V(n) asm volatile("s_waitcnt vmcnt(" #n ")" ::: "memory")
#define PG8_WAIT_L(n) asm volatile("s_waitcnt lgkmcnt(" #n ")" ::: "memory")
#define PG8_BAR __builtin_amdgcn_s_barrier()
#define PG8_SCHED __builtin_amdgcn_sched_barrier(0)
    Unit cur, nxt; int ui = 0;
    if (!S.next(0, cur)) return;
    f32x4 acc[2][2][4][2];
#pragma unroll
    for (int a = 0; a < 2; ++a)
#pragma unroll
        for (int b = 0; b < 2; ++b)
#pragma unroll
            for (int m = 0; m < 4; ++m)
#pragma unroll
                for (int n = 0; n < 2; ++n) acc[a][b][m][n] = (f32x4){0.f, 0.f, 0.f, 0.f};
    bf16x8 At[4][2], B0[2][2], B1[2][2];
    const char* cA = (const char*)g.A + (long)cur.arow * rstep; const char* cB = (const char*)g.Bt + (size_t)cur.pn * tstep;
    if constexpr (SP2) {
        PG8_STAGE(PG8_SB(0, 0), cB, voffB); PG8_STAGE(PG8_SB(0, 1), cB + hstep, voffB); PG8_STAGE(PG8_SA(0, 0), cA, voffA); PG8_STAGE(PG8_SA(0, 1), cA + hstep, voffA);
        if (wr == 1) PG8_BAR;
        PG8_WAIT_V(2); PG8_BAR;
        PG8_STAGE(PG8_SB(1, 0), cB + kstep, voffB); PG8_STAGE(PG8_SA(1, 0), cA + kstep, voffA); PG8_STAGE(PG8_SB(1, 1), cB + hstep + kstep, voffB);
        PG8_WAIT_V(6); PG8_BAR;
    } else {
        PG8_STAGE(PG8_SB(0, 0), cB, voffB); PG8_STAGE(PG8_SA(0, 0), cA, voffA); PG8_STAGE(PG8_SB(0, 1), cB + hstep, voffB); PG8_STAGE(PG8_SA(0, 1), cA + hstep, voffA);
        if (wr == 1) PG8_BAR;
        PG8_WAIT_V(4); PG8_BAR;
        PG8_STAGE(PG8_SB(1, 0), cB + kstep, voffB); PG8_STAGE(PG8_SA(1, 0), cA + kstep, voffA); PG8_STAGE(PG8_SB(1, 1), cB + hstep + kstep, voffB);
        PG8_WAIT_V(6); PG8_BAR;
    }
    for (;;) {
        const bool has_next = S.next(ui + 1, nxt);
        const char* nA = has_next ? (const char*)g.A + (long)nxt.arow * rstep : cA; const char* nB = has_next ? (const char*)g.Bt + (size_t)nxt.pn * tstep : cB;
        for (int t = 0; t < nt; t += 2) {
            const bool last = (t == nt - 2);
            const char* a1 = cA + (size_t)(t + 1) * kstep;
            const char* a2 = last ? nA : cA + (size_t)(t + 2) * kstep; const char* b2 = last ? nB : cB + (size_t)(t + 2) * kstep;
            const char* a3 = a2 + kstep; const char* b3 = b2 + kstep;
            if constexpr (SP2) {
            PG8_LDB(B0, 0, 0); PG8_LDB(B1, 0, 1); PG8_SCHED; PG8_LDA(At, 0, 0); PG8_STAGE(PG8_SA(1, 1), a1 + hstep, voffA);
            PG8_WAIT_V(8); PG8_WAIT_L(0); PG8_BAR; PG8_MMA(0, 0, At, B0); PG8_MMA(0, 1, At, B1); PG8_BAR; PG8_SCHED;
            PG8_LDA(At, 0, 1); PG8_STAGE(PG8_SB(0, 0), b2, voffB); PG8_STAGE(PG8_SB(0, 1), b2 + hstep, voffB); PG8_STAGE(PG8_SA(0, 0), a2, voffA);
            PG8_WAIT_V(8); PG8_WAIT_L(0); PG8_BAR; PG8_MMA(1, 0, At, B0); PG8_MMA(1, 1, At, B1); PG8_BAR; PG8_SCHED;
            PG8_LDB(B0, 1, 0); PG8_LDB(B1, 1, 1); PG8_SCHED; PG8_LDA(At, 1, 0); PG8_STAGE(PG8_SA(0, 1), a2 + hstep, voffA);
            PG8_WAIT_V(8); PG8_WAIT_L(0); PG8_BAR; PG8_MMA(0, 0, At, B0); PG8_MMA(0, 1, At, B1); PG8_BAR; PG8_SCHED;
            PG8_LDA(At, 1, 1); PG8_STAGE(PG8_SB(1, 0), b3, voffB); PG8_STAGE(PG8_SB(1, 1), b3 + hstep, voffB); PG8_STAGE(PG8_SA(1, 0), a3, voffA);
            PG8_WAIT_V(8); PG8_WAIT_L(0); PG8_BAR; PG8_MMA(1, 0, At, B0); PG8_MMA(1, 1, At, B1); PG8_BAR; PG8_SCHED;
            } else {
            PG8_LDB(B0, 0, 0); PG8_SCHED; PG8_LDA(At, 0, 0); PG8_STAGE(PG8_SA(1, 1), a1 + hstep, voffA);
            PG8_WAIT_L(8); PG8_BAR; PG8_WAIT_L(0); PG8_MMA(0, 0, At, B0); PG8_BAR; PG8_SCHED;
            PG8_LDB(B1, 0, 1); PG8_STAGE(PG8_SB(0, 0), b2, voffB);
            PG8_BAR; PG8_WAIT_L(0); PG8_MMA(0, 1, At, B1); PG8_BAR;
            PG8_LDA(At, 0, 1); PG8_STAGE(PG8_SA(0, 0), a2, voffA);
            PG8_BAR; PG8_WAIT_L(0); PG8_MMA(1, 0, At, B0); PG8_BAR; PG8_SCHED;
            PG8_STAGE(PG8_SB(0, 1), b2 + hstep, voffB);
            PG8_WAIT_V(6); PG8_BAR; PG8_MMA(1, 1, At, B1); PG8_BAR;
            PG8_LDB(B0, 1, 0); PG8_SCHED; PG8_LDA(At, 1, 0); PG8_STAGE(PG8_SA(0, 1), a2 + hstep, voffA);
            PG8_WAIT_L(8); PG8_BAR; PG8_WAIT_L(0); PG8_MMA(0, 0, At, B0); PG8_BAR; PG8_SCHED;
            PG8_LDB(B1, 1, 1); PG8_STAGE(PG8_SB(1, 0), b3, voffB);
            PG8_BAR; PG8_WAIT_L(0); PG8_MMA(0, 1, At, B1); PG8_BAR;
            PG8_LDA(At, 1, 1); PG8_STAGE(PG8_SA(1, 0), a3, voffA);
            PG8_BAR; PG8_WAIT_L(0); PG8_MMA(1, 0, At, B0); PG8_BAR; PG8_SCHED;
            PG8_STAGE(PG8_SB(1, 1), b3 + hstep, voffB);
            PG8_WAIT_V(6); PG8_BAR; PG8_MMA(1, 1, At, B1); PG8_BAR;
            }
        }
        if constexpr (ALIGN_EPI) { if (wr == 0) PG8_BAR; }
        E(acc, cur, wr, wc, fr, fq, lds + STAGE_BYTES);
        if (!has_next) break;
#pragma unroll
        for (int a = 0; a < 2; ++a)
#pragma unroll
            for (int b = 0; b < 2; ++b)
#pragma unroll
                for (int m = 0; m < 4; ++m)
#pragma unroll
                    for (int n = 0; n < 2; ++n) acc[a][b][m][n] = (f32x4){0.f, 0.f, 0.f, 0.f};
        cur = nxt; cA = nA; cB = nB; ++ui;
        if constexpr (ALIGN_EPI) { if (wr == 1) PG8_BAR; }
    }
    PG8_WAIT_V(0);
    if constexpr (!ALIGN_EPI) { if (wr == 0) PG8_BAR; }
    PG8_BAR;
#undef PG8_SA
#undef PG8_SB
#undef PG8_STAGE
#undef PG8_LDA
#undef PG8_LDB
#undef PG8_MMA
#undef PG8_WAIT_V
#undef PG8_WAIT_L
#undef PG8_BAR
#undef PG8_SCHED
}
}

constexpr int NWAVES = 8, NTHREADS = NWAVES * 64;
constexpr int LDS_BYTES = 147456;
#define LAS __attribute__((address_space(3)))
typedef unsigned short bf16;
typedef unsigned v4u __attribute__((ext_vector_type(4)));
typedef unsigned v2u __attribute__((ext_vector_type(2)));
typedef float f32x4 __attribute__((ext_vector_type(4)));
#define LDS_WAIT() asm volatile("s_waitcnt lgkmcnt(0)" ::: "memory")
__device__ __forceinline__ unsigned f2bf(float f) { unsigned u = __builtin_bit_cast(unsigned, f); return (u + 0x7fffu + ((u >> 16) & 1u)) >> 16; }
__device__ __forceinline__ unsigned pk2(float lo, float hi) { return f2bf(lo) | (f2bf(hi) << 16); }
__device__ __forceinline__ float bflo(unsigned w) { return __uint_as_float(w << 16); }
__device__ __forceinline__ float bfhi(unsigned w) { return __uint_as_float(w & 0xffff0000u); }
__device__ __forceinline__ float wave_sum(float v) {
#pragma unroll
    for (int o = 1; o < 64; o <<= 1) v += __shfl_xor(v, o);
    return v;
}


typedef short bf16x8 __attribute__((ext_vector_type(8)));
typedef short s16x4 __attribute__((ext_vector_type(4)));
typedef float f32x16 __attribute__((ext_vector_type(16)));
#define MFMA32(a, b, c) __builtin_amdgcn_mfma_f32_32x32x16_bf16((a), (b), (c), 0, 0, 0)
__device__ __forceinline__ int crow(int reg, int h) { return (reg & 3) + 8 * (reg >> 2) + 4 * h; }
__device__ __forceinline__ bf16x8 rowfrag(const LAS unsigned char* tile, int stride, int row, int k0) { return *(const LAS bf16x8*)(tile + row * stride + k0 * 2); }
__device__ __forceinline__ bf16x8 trfrag(const LAS unsigned char* tile, int stride, int k0, int col0, int lane, bool perm) {
    const int g = lane >> 4, i = lane & 15, hh = g >> 1;
    const int rowA = k0 + (perm ? 4 * hh : 8 * hh) + (i >> 2), rowB = rowA + (perm ? 8 : 4), col = col0 + 16 * (g & 1) + 4 * (i & 3);
    const s16x4 lo = __builtin_bit_cast(s16x4, __builtin_amdgcn_ds_read_tr16_b64_v4i16((LAS s16x4*)(tile + rowA * stride + col * 2)));
    const s16x4 hi = __builtin_bit_cast(s16x4, __builtin_amdgcn_ds_read_tr16_b64_v4i16((LAS s16x4*)(tile + rowB * stride + col * 2)));
    return (bf16x8){lo[0], lo[1], lo[2], lo[3], hi[0], hi[1], hi[2], hi[3]};
}
typedef float f32x2_t __attribute__((ext_vector_type(2))); typedef __bf16 bf16x2_t __attribute__((ext_vector_type(2)));
__device__ __forceinline__ unsigned cvtpk_s(float lo, float hi) { f32x2_t v = {lo, hi}; bf16x2_t b = __builtin_convertvector(v, bf16x2_t); return __builtin_bit_cast(unsigned, b); }
__device__ __forceinline__ bf16x8 pack_acc8(const f32x16& x, int s) {
    v4u w; w.x = cvtpk_s(x[8 * s + 0], x[8 * s + 1]); w.y = cvtpk_s(x[8 * s + 2], x[8 * s + 3]); w.z = cvtpk_s(x[8 * s + 4], x[8 * s + 5]); w.w = cvtpk_s(x[8 * s + 6], x[8 * s + 7]);
    return __builtin_bit_cast(bf16x8, w);
}
__device__ __forceinline__ float bf2f(unsigned short h) { return __uint_as_float((unsigned)h << 16); }

constexpr int GL_T = 0;
constexpr int GL_QS = 2048, GL_KS = GL_QS + 64 * 144, GL_VT = GL_KS + 64 * 144, GL_OT = GL_VT + 64 * 272;
constexpr int GL_END = GL_OT + 64 * 528;
constexpr int SW_KS = 0, SW_VS = 256 * 144, SW_LS = 2 * 256 * 144, SW_END = SW_LS + 8 * 128;
static_assert(GL_END <= 131072 && SW_END <= 131072, "mixer LDS");

__device__ __forceinline__ void gla_prep(const float* LA, size_t row0, int h, int lane, int wave, LAS unsigned char* lds, float (&b)[8], float& blast) {
    LAS float* T = (LAS float*)(lds + GL_T);
    float run = 0.f;
#pragma unroll
    for (int i = 0; i < 8; ++i) { run += LA[(row0 + 8 * wave + i) * 256 + h * 64 + lane]; b[i] = run; }
    T[wave * 64 + lane] = run;
    __syncthreads();
    float off = 0.f, tot = 0.f;
#pragma unroll
    for (int g = 0; g < 8; ++g) { const float t = T[g * 64 + lane]; tot += t; off += (g < wave) ? t : 0.f; }
#pragma unroll
    for (int i = 0; i < 8; ++i) b[i] += off;
    blast = tot;
}

struct Args {
    const float* x; const int* pos; const float* g_pre; const float* w_in; const float* gate_up; const float* gate_bias; const float* g_gla; const float* sinks;
    const float* w_out; const float* g_postmix; const float* g_preffn; const float* w_up; const float* conv_w; const float* conv_b; const float* w_down; const float* g_postffn;
    float* out; unsigned char* ws; int ph_lo, ph_hi;
};

__device__ __forceinline__ void p0_transpose_item(const float* W, int ldw, int col0, int K, bf16* WT, int mode, int rowoff, const float* gain, LAS float* scr, int kb, int nb, int lane) {
    const int k0 = 64 * kb, n0 = 32 * nb;
#pragma unroll 8
    for (int i = 0; i < 32; ++i) { const int kk = 2 * i + (lane >> 5); float v = W[(size_t)(k0 + kk) * ldw + col0 + n0 + (lane & 31)]; if (gain) v *= gain[k0 + kk]; scr[kk * 33 + (lane & 31)] = v; }
    LDS_WAIT(); asm volatile("" ::: "memory");
    const int c = lane & 7;
#pragma unroll
    for (int j = 0; j < 4; ++j) { const int n = (lane >> 3) + 8 * j; const LAS float* s = scr + (8 * c) * 33 + n;
        v4u o; o.x = pk2(s[0 * 33], s[1 * 33]); o.y = pk2(s[2 * 33], s[3 * 33]); o.z = pk2(s[4 * 33], s[5 * 33]); o.w = pk2(s[6 * 33], s[7 * 33]);
        const int nn = n0 + n; int dr;
        if (mode == 0) dr = rowoff + nn;
        else dr = (nn < DFF) ? ((nn >> 7) * 256 + (nn & 127)) : (((nn - DFF) >> 7) * 256 + 128 + ((nn - DFF) & 127));
        *(v4u*)(WT + (size_t)dr * K + k0 + 8 * c) = o; }
    LDS_WAIT(); asm volatile("" ::: "memory");
}

__global__ void __launch_bounds__(NTHREADS, 2) fwd(Args a) {
    extern __shared__ __attribute__((aligned(16))) unsigned char lds_raw[];
    LAS unsigned char* lds = (LAS unsigned char*)lds_raw;
    const int tid = threadIdx.x, lane = tid & 63, wave = __builtin_amdgcn_readfirstlane(tid >> 6);
    const int G = gridDim.x, bid = blockIdx.x;
    const int gw = bid * NWAVES + wave, NGW = G * NWAVES;
    unsigned char* ws = a.ws;
    bf16* Wt_in = (bf16*)(ws + WS_WIN); bf16* Wt_out = (bf16*)(ws + WS_WOUT); bf16* Wt_up = (bf16*)(ws + WS_WUP); bf16* Wt_dn = (bf16*)(ws + WS_WDN);
    float* rope = (float*)(ws + WS_ROPE); float* rs0 = (float*)(ws + WS_RS0); float* rs1 = (float*)(ws + WS_RS1); float* part = (float*)(ws + WS_PART);
    bf16* XB = (bf16*)(ws + WS_XB); bf16* Y = (bf16*)(ws + WS_XB);
    bf16* GQ = (bf16*)(ws + WS_GQ); bf16* GK = (bf16*)(ws + WS_GK); bf16* GV = (bf16*)(ws + WS_GV); float* LA = (float*)(ws + WS_LA); bf16* GG = (bf16*)(ws + WS_GG);
    bf16* SQ = (bf16*)(ws + WS_SQ); bf16* SK = (bf16*)(ws + WS_SK); bf16* SV = (bf16*)(ws + WS_SV);
    bf16* ACT = (bf16*)(ws + WS_ACT); float* UT = (float*)(ws + WS_U); bf16* ST = (bf16*)(ws + WS_S); bf16* MIX = (bf16*)(ws + WS_MIX); bf16* X1B = (bf16*)(ws + WS_X1B);
    const int lo = a.ph_lo, hi = a.ph_hi;
#ifndef PH_MASK
#define PH_MASK 0x3ff
#endif
#define IN(k) (((PH_MASK >> (k)) & 1) && lo <= (k) && (k) < hi)
#define BOTH(k) (IN(k) && IN((k) + 1))
#if MK_ONE_LAUNCH
#define GRID_BAR() cg::this_grid().sync()
#else
#define GRID_BAR() do { } while (0)
#endif

    if (IN(0)) {
        LAS float* scr = (LAS float*)(lds + wave * 16384);
        constexpr int I_A = 16 * 32, I_B = 16 * 40, I_O = 16 * 32, I_U = 16 * 176, I_D = 44 * 32;
        constexpr int NITEMS = I_A + I_B + I_O + I_U + I_D;
        for (int it = gw; it < NITEMS; it += NGW) {
            int r = it;
            if (r < I_A) { p0_transpose_item(a.w_in, IN_W, 0, DM, Wt_in, 0, 0, a.g_pre, scr, r / 32, r % 32, lane); continue; } r -= I_A;
            if (r < I_B) { p0_transpose_item(a.w_in, IN_W, 1040, DM, Wt_in, 0, 1280, a.g_pre, scr, r / 40, r % 40, lane); continue; } r -= I_B;
            if (r < I_O) { p0_transpose_item(a.w_out, DM, 0, DM, Wt_out, 0, 0, nullptr, scr, r / 32, r % 32, lane); continue; } r -= I_O;
            if (r < I_U) { p0_transpose_item(a.w_up, NUP, 0, DM, Wt_up, 1, 0, a.g_preffn, scr, r / 176, r % 176, lane); continue; } r -= I_U;
            p0_transpose_item(a.w_down, DM, 0, DFF, Wt_dn, 0, 0, nullptr, scr, r / 32, r % 32, lane);
        }
        for (int idx = bid * NTHREADS + tid; idx < 256 * DM; idx += G * NTHREADS) { const int j = idx >> 10, k = idx & 1023;
            const float* wr_ = a.w_in + (size_t)k * IN_W + 1024; float s = 0.f;
#pragma unroll
            for (int r = 0; r < 16; ++r) s += wr_[r] * a.gate_up[r * 256 + j];
            Wt_in[(size_t)(1024 + j) * DM + k] = (bf16)f2bf(s * a.g_pre[k]); }
        for (int idx = bid * NTHREADS + tid; idx < M * 8; idx += G * NTHREADS) { const int row = idx >> 3, i = idx & 7;
            const float invf[8] = {1.0f, 0.1939227432012558f, 0.03760603070259094f, 0.007292664609849453f, 0.0014142135623842478f, 0.00027424818836152554f, 5.318296098266728e-05f, 1.0313386155758053e-05f};
            float inv = invf[0];
#pragma unroll
            for (int q = 1; q < 8; ++q) inv = (i == q) ? invf[q] : inv;
            const float ang = (float)a.pos[row] * inv;
            const double rev = (double)ang * 0.15915494309189535; const float fr_ = (float)(rev - __builtin_floor(rev));
            rope[(size_t)row * 16 + i] = __builtin_amdgcn_cosf(fr_); rope[(size_t)row * 16 + 8 + i] = __builtin_amdgcn_sinf(fr_); }
        for (int m = gw; m < M; m += NGW) { const f32x4* xr = (const f32x4*)(a.x + (size_t)m * DM) + lane; f32x4 v[4]; float s = 0.f;
#pragma unroll
            for (int j = 0; j < 4; ++j) { v[j] = xr[64 * j]; s += (v[j].x * v[j].x + v[j].y * v[j].y) + (v[j].z * v[j].z + v[j].w * v[j].w); }
            s = wave_sum(s); if (lane == 0) rs0[m] = 1.0f / sqrtf(s * (1.0f / DM) + EPS);
            v2u* o8 = (v2u*)(XB + (size_t)m * DM) + lane;
#pragma unroll
            for (int j = 0; j < 4; ++j) { v2u w; w.x = pk2(v[j].x, v[j].y); w.y = pk2(v[j].z, v[j].w); o8[64 * j] = w; } }
        if (BOTH(0)) GRID_BAR();
    }

    if (IN(1)) {
        pg8::Gemm g{XB, Wt_in, DM}; pg8::StaticOrder S; S.init(M, NIN, G, bid);
        pg8::EpiIn E{rs0, rope, a.gate_bias, GQ, GK, GV, GG, SQ, SK, SV, LA};
        pg8::gemm_phase<pg8::EpiIn, pg8::StaticOrder>(lds, g, S, E);
        if (BOTH(1)) GRID_BAR();
    }

    if (IN(2)) {
        for (int unit = bid; unit < 4096; unit += G) { const int bh = unit >> 7, c = unit & 127, b_ = bh >> 2, h = bh & 3; const size_t row0 = (size_t)b_ * SEQ + c * 64;
            v4u vp[2];
#pragma unroll
            for (int i = 0; i < 2; ++i) { const int pc = tid + 512 * i, r = pc >> 4, cs = pc & 15; vp[i] = *(const v4u*)(GV + (row0 + r) * 512 + h * 128 + cs * 8); }
            unsigned short kk[8];
#pragma unroll
            for (int i = 0; i < 8; ++i) kk[i] = GK[(row0 + 8 * wave + i) * 256 + h * 64 + lane];
            float bb[8], blast; gla_prep(LA, row0, h, lane, wave, lds, bb, blast);
            { float e[8];
#pragma unroll
              for (int i = 0; i < 8; ++i) e[i] = bf2f(kk[i]) * __builtin_amdgcn_exp2f((blast - bb[i]) * LOG2E);
              v4u w; w.x = pk2(e[0], e[1]); w.y = pk2(e[2], e[3]); w.z = pk2(e[4], e[5]); w.w = pk2(e[6], e[7]);
              *(LAS v4u*)(lds + GL_KS + lane * 144 + wave * 16) = w; }
#pragma unroll
            for (int i = 0; i < 2; ++i) { const int pc = tid + 512 * i, r = pc >> 4, cs = pc & 15; *(LAS v4u*)(lds + GL_VT + r * 272 + cs * 16) = vp[i]; }
            if (wave == 0) ((float*)(ws + WS_GDEC))[(size_t)unit * 64 + lane] = __builtin_amdgcn_exp2f(blast * LOG2E);
            __syncthreads();
            { const int mb = wave >> 1, nb = wave & 1, r = lane & 31, hh = lane >> 5;
              f32x16 acc = {};
#pragma unroll
              for (int ks = 0; ks < 4; ++ks) { const bf16x8 A = trfrag(lds + GL_VT, 272, 16 * ks, 32 * mb, lane, false); const bf16x8 B = rowfrag(lds + GL_KS, 144, 32 * nb + r, 16 * ks + 8 * hh); acc = MFMA32(A, B, acc); }
              float* ut = UT + (size_t)unit * 8192 + 32 * nb + r;
#pragma unroll
              for (int reg = 0; reg < 16; ++reg) ut[(32 * mb + crow(reg, hh)) * 64] = acc[reg]; }
            __syncthreads();
        }
        for (int unit = bid; unit < BATCH * 2 * 64; unit += G) { const int qb = unit & 63, kvh = (unit >> 6) & 1, b_ = unit >> 7; const size_t rowq = (size_t)b_ * SEQ + qb * 128;
#pragma unroll
            for (int i = 0; i < 4; ++i) { const int pc = tid + 512 * i, key = pc >> 3, sg = pc & 7; v4u kv = (v4u){0u, 0u, 0u, 0u}, vv = kv;
                if (qb > 0 || key >= 128) { const size_t kr = rowq - 128 + key; kv = *(const v4u*)(SK + kr * 128 + kvh * 64 + sg * 8); vv = *(const v4u*)(SV + kr * 128 + kvh * 64 + sg * 8); }
                *(LAS v4u*)(lds + SW_KS + key * 144 + sg * 16) = kv; *(LAS v4u*)(lds + SW_VS + key * 144 + sg * 16) = vv; }
            __syncthreads();
            { const int hq = kvh * 4 + (wave >> 1), r = lane & 31, hh = lane >> 5; const float sink2 = a.sinks[hq] * LOG2E; LAS float* LS = (LAS float*)(lds + SW_LS) + wave * 32;
              for (int qt = 0; qt < 2; ++qt) { const int i0 = (wave & 1) * 64 + qt * 32, kt0 = i0 >> 5;
                  bf16x8 qf[4];
#pragma unroll
                  for (int ks = 0; ks < 4; ++ks) qf[ks] = *(const bf16x8*)(SQ + (rowq + i0 + r) * 512 + hq * 64 + 16 * ks + 8 * hh);
                  f32x16 X[5];
#pragma unroll
                  for (int t = 0; t < 5; ++t) { X[t] = (f32x16){};
#pragma unroll
                      for (int ks = 0; ks < 4; ++ks) X[t] = MFMA32(rowfrag(lds + SW_KS, 144, 32 * (kt0 + t) + r, 16 * ks + 8 * hh), qf[ks], X[t]); }
                  const int kq = 128 + i0 + r; float mx = sink2;
#pragma unroll
                  for (int t = 0; t < 5; ++t)
#pragma unroll
                      for (int reg = 0; reg < 16; ++reg) { const int kx = 32 * (kt0 + t) + crow(reg, hh); const bool ok = (kx <= kq) && (kx > kq - 128) && (qb > 0 || kx >= 128);
                          const float v = ok ? X[t][reg] : -INFINITY; X[t][reg] = v; mx = __builtin_fmaxf(mx, v); }
                  mx = __builtin_fmaxf(mx, __shfl_xor(mx, 32));
                  float l = 0.f;
#pragma unroll
                  for (int t = 0; t < 5; ++t)
#pragma unroll
                      for (int reg = 0; reg < 16; ++reg) { const float pv = __builtin_amdgcn_exp2f(X[t][reg] - mx); X[t][reg] = pv; l += pv; }
                  l += __shfl_xor(l, 32); l += __builtin_amdgcn_exp2f(sink2 - mx);
                  if (hh == 0) LS[r] = l;
                  f32x16 O0 = {}, O1 = {};
#pragma unroll
                  for (int t = 0; t < 5; ++t)
#pragma unroll
                      for (int s2 = 0; s2 < 2; ++s2) { const bf16x8 pa = pack_acc8(X[t], s2);
                          O0 = MFMA32(pa, trfrag(lds + SW_VS, 144, 32 * (kt0 + t) + 16 * s2, 0, lane, true), O0);
                          O1 = MFMA32(pa, trfrag(lds + SW_VS, 144, 32 * (kt0 + t) + 16 * s2, 32, lane, true), O1); }
                  LDS_WAIT();
                  bf16* op = MIX + (rowq + i0) * DM + 512 + hq * 64 + r;
#pragma unroll
                  for (int reg = 0; reg < 16; ++reg) { const int row = crow(reg, hh); const float rl = 1.0f / LS[row];
                      op[(size_t)row * DM] = (bf16)f2bf(O0[reg] * rl); op[(size_t)row * DM + 32] = (bf16)f2bf(O1[reg] * rl); }
                  LDS_WAIT();
              } }
            __syncthreads();
        }
        if (BOTH(2)) GRID_BAR();
    }

    if (IN(3)) {
        const float* GD = (const float*)(ws + WS_GDEC);
        for (int e = bid * NTHREADS + tid; e < 32 * 4096; e += G * NTHREADS) { const int bh = e >> 12, rem = e & 4095, dv = rem >> 5, dk = (rem & 31) * 2;
            float s0 = 0.f, s1 = 0.f;
            const size_t base = (size_t)bh * 128 * 8192 + dv * 64 + dk;
#pragma unroll 8
            for (int c = 0; c < 128; ++c) { const float2 u = *(const float2*)(UT + base + (size_t)c * 8192); const float2 g = *(const float2*)(GD + ((size_t)bh * 128 + c) * 64 + dk);
                *(unsigned*)(ST + base + (size_t)c * 8192) = pk2(s0, s1);
                s0 = g.x * s0 + u.x; s1 = g.y * s1 + u.y; } }
        if (BOTH(3)) GRID_BAR();
    }

    if (IN(4)) {
        for (int unit = bid; unit < 4096; unit += G) { const int bh = unit >> 7, c = unit & 127, b_ = bh >> 2, h = bh & 3; const size_t row0 = (size_t)b_ * SEQ + c * 64;
            v4u vp[2];
#pragma unroll
            for (int i = 0; i < 2; ++i) { const int pc = tid + 512 * i, r = pc >> 4, cs = pc & 15; vp[i] = *(const v4u*)(GV + (row0 + r) * 512 + h * 128 + cs * 8); }
            unsigned short kk[8], qq[8];
#pragma unroll
            for (int i = 0; i < 8; ++i) { kk[i] = GK[(row0 + 8 * wave + i) * 256 + h * 64 + lane]; qq[i] = GQ[(row0 + 8 * wave + i) * 256 + h * 64 + lane]; }
            float bb[8], blast; gla_prep(LA, row0, h, lane, wave, lds, bb, blast);
#pragma unroll
            for (int i = 0; i < 8; ++i) { const float ep = __builtin_amdgcn_exp2f(bb[i] * LOG2E), en = __builtin_amdgcn_exp2f(-bb[i] * LOG2E);
                *(LAS unsigned short*)(lds + GL_QS + (8 * wave + i) * 144 + lane * 2) = (unsigned short)f2bf(bf2f(qq[i]) * ep);
                *(LAS unsigned short*)(lds + GL_KS + (8 * wave + i) * 144 + lane * 2) = (unsigned short)f2bf(bf2f(kk[i]) * en); }
#pragma unroll
            for (int i = 0; i < 2; ++i) { const int pc = tid + 512 * i, r = pc >> 4, cs = pc & 15; *(LAS v4u*)(lds + GL_VT + r * 272 + cs * 16) = vp[i]; }
            __syncthreads();
            { const int ib = wave >> 2, nb = wave & 3, r = lane & 31, hh = lane >> 5;
              bf16x8 st[4];
#pragma unroll
              for (int ks = 0; ks < 4; ++ks) st[ks] = *(const bf16x8*)(ST + (size_t)unit * 8192 + (32 * nb + r) * 64 + 16 * ks + 8 * hh);
              f32x16 o = {};
              for (int jb = 0; jb <= ib; ++jb) { f32x16 X = {};
#pragma unroll
                  for (int ks = 0; ks < 4; ++ks) X = MFMA32(rowfrag(lds + GL_KS, 144, 32 * jb + r, 16 * ks + 8 * hh), rowfrag(lds + GL_QS, 144, 32 * ib + r, 16 * ks + 8 * hh), X);
                  if (jb == ib) {
#pragma unroll
                      for (int reg = 0; reg < 16; ++reg) X[reg] = (crow(reg, hh) > r) ? 0.f : X[reg]; }
#pragma unroll
                  for (int s2 = 0; s2 < 2; ++s2) o = MFMA32(pack_acc8(X, s2), trfrag(lds + GL_VT, 272, 32 * jb + 16 * s2, 32 * nb, lane, true), o); }
#pragma unroll
              for (int ks = 0; ks < 4; ++ks) o = MFMA32(rowfrag(lds + GL_QS, 144, 32 * ib + r, 16 * ks + 8 * hh), st[ks], o);
              LAS float* ot = (LAS float*)(lds + GL_OT) + 32 * nb + r;
#pragma unroll
              for (int reg = 0; reg < 16; ++reg) ot[(32 * ib + crow(reg, hh)) * 132] = o[reg]; }
            __syncthreads();
            { const int row = tid >> 3, sg = tid & 7; const LAS f32x4* op = (const LAS f32x4*)(lds + GL_OT + row * 528 + sg * 64);
              f32x4 ov[4]; float ss = 0.f;
#pragma unroll
              for (int q = 0; q < 4; ++q) { ov[q] = op[q]; ss += (ov[q].x * ov[q].x + ov[q].y * ov[q].y) + (ov[q].z * ov[q].z + ov[q].w * ov[q].w); }
              ss += __shfl_xor(ss, 1); ss += __shfl_xor(ss, 2); ss += __shfl_xor(ss, 4);
              const float rs = 1.0f / sqrtf(ss * (1.0f / 128.0f) + EPS);
              const v4u g0 = *(const v4u*)(GG + (row0 + row) * 512 + h * 128 + sg * 16), g1 = *(const v4u*)(GG + (row0 + row) * 512 + h * 128 + sg * 16 + 8);
              const f32x4* wp = (const f32x4*)(a.g_gla + sg * 16); const f32x4 w0 = wp[0], w1 = wp[1], w2 = wp[2], w3 = wp[3];
              v4u o0, o1;
              o0.x = pk2(ov[0].x * rs * w0.x * bflo(g0.x), ov[0].y * rs * w0.y * bfhi(g0.x)); o0.y = pk2(ov[0].z * rs * w0.z * bflo(g0.y), ov[0].w * rs * w0.w * bfhi(g0.y));
              o0.z = pk2(ov[1].x * rs * w1.x * bflo(g0.z), ov[1].y * rs * w1.y * bfhi(g0.z)); o0.w = pk2(ov[1].z * rs * w1.z * bflo(g0.w), ov[1].w * rs * w1.w * bfhi(g0.w));
              o1.x = pk2(ov[2].x * rs * w2.x * bflo(g1.x), ov[2].y * rs * w2.y * bfhi(g1.x)); o1.y = pk2(ov[2].z * rs * w2.z * bflo(g1.y), ov[2].w * rs * w2.w * bfhi(g1.y));
              o1.z = pk2(ov[3].x * rs * w3.x * bflo(g1.z), ov[3].y * rs * w3.y * bfhi(g1.z)); o1.w = pk2(ov[3].z * rs * w3.z * bflo(g1.w), ov[3].w * rs * w3.w * bfhi(g1.w));
              bf16* mp = MIX + (row0 + row) * DM + h * 128 + sg * 16; *(v4u*)mp = o0; *(v4u*)(mp + 8) = o1; }
            __syncthreads();
        }
        if (BOTH(4)) GRID_BAR();
    }

    if (IN(5)) {
        pg8::Gemm g{MIX, Wt_out, DM}; pg8::StaticOrder S; S.init(M, DM, G, bid);
        pg8::EpiY E{Y, part};
        pg8::gemm_phase<pg8::EpiY, pg8::StaticOrder>(lds, g, S, E);
        if (BOTH(5)) GRID_BAR();
    }

    if (IN(6)) {
        for (int m = gw; m < M; m += NGW) {
            float p = (lane < 16) ? part[(size_t)m * 16 + lane] : 0.f; p = wave_sum(p);
            const float rs = 1.0f / sqrtf(p * (1.0f / DM) + EPS);
            const f32x4* xr = (const f32x4*)(a.x + (size_t)m * DM) + lane; const v2u* yr = (const v2u*)(Y + (size_t)m * DM) + lane; const f32x4* gr = (const f32x4*)a.g_postmix + lane;
            f32x4* orow = (f32x4*)(a.out + (size_t)m * DM) + lane; v2u* xb = (v2u*)(X1B + (size_t)m * DM) + lane; float s = 0.f;
#pragma unroll
            for (int j = 0; j < 4; ++j) { const f32x4 xv = xr[64 * j], gv = gr[64 * j]; const v2u yw = yr[64 * j];
                f32x4 r; r.x = xv.x + bflo(yw.x) * rs * gv.x; r.y = xv.y + bfhi(yw.x) * rs * gv.y; r.z = xv.z + bflo(yw.y) * rs * gv.z; r.w = xv.w + bfhi(yw.y) * rs * gv.w;
                s += (r.x * r.x + r.y * r.y) + (r.z * r.z + r.w * r.w);
                orow[64 * j] = r; v2u w; w.x = pk2(r.x, r.y); w.y = pk2(r.z, r.w); xb[64 * j] = w; }
            s = wave_sum(s); if (lane == 0) rs1[m] = 1.0f / sqrtf(s * (1.0f / DM) + EPS); }
        if (BOTH(6)) GRID_BAR();
    }

    if (IN(7)) {
        pg8::Gemm g{X1B, Wt_up, DM}; pg8::UpOrder S{G, bid};
        pg8::EpiUp E{ACT, rs1, a.conv_w, a.conv_b};
        pg8::gemm_phase<pg8::EpiUp, pg8::UpOrder>(lds, g, S, E);
        if (BOTH(7)) GRID_BAR();
    }

    if (IN(8)) {
        pg8::Gemm g{ACT, Wt_dn, DFF}; pg8::StaticOrder S; S.init(M, DM, G, bid);
        pg8::EpiY E{Y, part};
        pg8::gemm_phase<pg8::EpiY, pg8::StaticOrder>(lds, g, S, E);
        if (BOTH(8)) GRID_BAR();
    }

    if (IN(9)) {
        for (int m = gw; m < M; m += NGW) {
            float p = (lane < 16) ? part[(size_t)m * 16 + lane] : 0.f; p = wave_sum(p);
            const float rs = 1.0f / sqrtf(p * (1.0f / DM) + EPS);
            const v2u* yr = (const v2u*)(Y + (size_t)m * DM) + lane; const f32x4* gr = (const f32x4*)a.g_postffn + lane; f32x4* orow = (f32x4*)(a.out + (size_t)m * DM) + lane;
#pragma unroll
            for (int j = 0; j < 4; ++j) { const f32x4 xv = orow[64 * j], gv = gr[64 * j]; const v2u yw = yr[64 * j];
                f32x4 r; r.x = xv.x + bflo(yw.x) * rs * gv.x; r.y = xv.y + bfhi(yw.x) * rs * gv.y; r.z = xv.z + bflo(yw.y) * rs * gv.z; r.w = xv.w + bfhi(yw.y) * rs * gv.w;
                orow[64 * j] = r; } }
    }
#undef IN
#undef BOTH
}

constexpr int N_PHASES = 10;

extern "C" void kernel_launch(void* const* d_in, const int* in_sizes, int n_in, void* d_out, int out_size, void* d_ws, size_t ws_size, hipStream_t stream) {
    static int grid = 0;
    if (grid == 0) {
        if (n_in != 16 || in_sizes[0] != M * DM || out_size != M * DM || ws_size < WS_END) { fprintf(stderr, "kernel_launch: unexpected shapes (n_in %d, in0 %d, out %d, ws %zu); nothing launched\n", n_in, n_in > 0 ? in_sizes[0] : -1, out_size, ws_size); grid = -1; return; }
        int dev = 0, cus = 0, per_cu = 0;
        if (hipGetDevice(&dev) != hipSuccess || hipDeviceGetAttribute(&cus, hipDeviceAttributeMultiprocessorCount, dev) != hipSuccess) { grid = -1; return; }
        if (hipFuncSetAttribute((const void*)fwd, hipFuncAttributeMaxDynamicSharedMemorySize, LDS_BYTES) != hipSuccess) { fprintf(stderr, "kernel_launch: hipFuncSetAttribute failed\n"); grid = -1; return; }
        if (hipOccupancyMaxActiveBlocksPerMultiprocessor(&per_cu, (const void*)fwd, NTHREADS, LDS_BYTES) != hipSuccess || per_cu < 1) { fprintf(stderr, "kernel_launch: occupancy query says %d\n", per_cu); per_cu = 1; }
        (void)hipGetLastError();
        grid = cus * (per_cu < 1 ? 1 : per_cu);
        if (grid > cus) grid = cus;
    }
    if (grid < 0) return;
    (void)hipMemsetAsync((char*)d_ws + WS_CTL, 0, CTL_ZERO_BYTES, stream);
    Args a{};
    a.x = (const float*)d_in[0]; a.pos = (const int*)d_in[1]; a.g_pre = (const float*)d_in[2]; a.w_in = (const float*)d_in[3]; a.gate_up = (const float*)d_in[4]; a.gate_bias = (const float*)d_in[5];
    a.g_gla = (const float*)d_in[6]; a.sinks = (const float*)d_in[7]; a.w_out = (const float*)d_in[8]; a.g_postmix = (const float*)d_in[9]; a.g_preffn = (const float*)d_in[10]; a.w_up = (const float*)d_in[11];
    a.conv_w = (const float*)d_in[12]; a.conv_b = (const float*)d_in[13]; a.w_down = (const float*)d_in[14]; a.g_postffn = (const float*)d_in[15];
    a.out = (float*)d_out; a.ws = (unsigned char*)d_ws;
#if MK_ONE_LAUNCH
    a.ph_lo = 0; a.ph_hi = N_PHASES;
    void* args[] = {&a};
    hipError_t e = hipLaunchCooperativeKernel((const void*)fwd, dim3(grid), dim3(NTHREADS), args, LDS_BYTES, stream);
    if (e != hipSuccess) fprintf(stderr, "kernel_launch: cooperative launch failed: %s (grid %d)\n", hipGetErrorString(e), grid);
#else
    for (int p = 0; p < N_PHASES; ++p) { a.ph_lo = p; a.ph_hi = p + 1; hipLaunchKernelGGL(fwd, dim3(grid), dim3(NTHREADS), LDS_BYTES, stream, a); }
#endif
}
```

```cpp
#include <hip/hip_runtime.h>
#include <hip/hip_cooperative_groups.h>
#include <cstdio>
#include <cstdint>
namespace cg = cooperative_groups;

#ifndef MK_ONE_LAUNCH
#define MK_ONE_LAUNCH 1
#endif

constexpr int BATCH = 8, SEQ = 8192, DM = 1024, M = BATCH * SEQ;
constexpr int IN_W = 2320, NIN = 2560;
constexpr int DFF = 2816, NUP = 2 * DFF;
constexpr float EPS = 1e-6f;
constexpr float LOG2E = 1.4426950408889634f;
constexpr float QSCALE = 0.125f * LOG2E;
constexpr int UP_TILE = 254, UP_MT = 33, UP_NT = 22, UP_UNITS = BATCH * UP_MT * UP_NT;

constexpr size_t MiB = 1u << 20;
constexpr size_t WS_CTL = 0, CTL_ZERO_BYTES = 1 * MiB;
constexpr size_t WS_WIN = 2 * MiB, WS_WOUT = 7 * MiB, WS_WUP = 9 * MiB, WS_WDN = 20 * MiB;
constexpr size_t WS_GDEC = 35 * MiB;
constexpr size_t WS_ROPE = 26 * MiB, WS_RS0 = 30 * MiB, WS_RS1 = 30 * MiB + 512 * 1024, WS_PART = 31 * MiB;
constexpr size_t WS_XB = 64 * MiB;
constexpr size_t WS_GQ = 192 * MiB, WS_GK = 224 * MiB, WS_GV = 256 * MiB, WS_LA = 320 * MiB, WS_GG = 384 * MiB, WS_SQ = 448 * MiB, WS_SK = 512 * MiB, WS_SV = 528 * MiB;
constexpr size_t WS_ACT = 192 * MiB;
constexpr size_t WS_U = 544 * MiB;
constexpr size_t WS_S = 672 * MiB;
constexpr size_t WS_MIX = 736 * MiB;
constexpr size_t WS_X1B = 864 * MiB;
constexpr size_t WS_END = 1024 * MiB;

namespace pg8 {
#define PG8_LAS __attribute__((address_space(3)))
typedef unsigned short bf16_t;
typedef short bf16x8 __attribute__((ext_vector_type(8)));
typedef float f32x4 __attribute__((ext_vector_type(4)));
typedef unsigned u32x4 __attribute__((ext_vector_type(4)));
constexpr int BM = 256, BK = 64, HALF = 128, HTB = HALF * BK * 2, STAGE_BYTES = 8 * HTB, NXCD = 8, WGM = 8;

__host__ __device__ __forceinline__ int lds_byte(int r, int c) { const int st = (r >> 4) * 2 + (c >> 5), rr = r & 15, cc = c & 31, ob = rr * 64 + cc * 2; return st * 1024 + (ob ^ (((ob >> 9) & 1) << 5)); }
__host__ __device__ __forceinline__ void stage_rc(int b, int& R, int& C) { const int st = b / 1024, sb = b % 1024, swz = sb ^ (((sb >> 9) & 1) << 5); R = (st >> 1) * 16 + swz / 64; C = (st & 1) * 32 + (swz % 64) / 2; }
__host__ __device__ __forceinline__ int perm32(int rho) { const int n = rho >> 4, i = rho & 15; return 8 * (i >> 2) + 4 * n + (i & 3); }

struct Unit { int pm, pn, arow, aux; };
struct Gemm { const bf16_t* A; const bf16_t* Bt; int K; };

struct StaticOrder {
    int nM, nN, nwg, G, c;
    __device__ void init(int M_, int N_, int G_, int c_) { nM = M_ / BM; nN = N_ / BM; nwg = nM * nN; G = G_; c = c_; }
    __device__ bool next(int i, Unit& u) const {
        const long L = (long)i * G + c; if (L >= nwg) return false;
        int wgid = (int)L; { const int q = nwg / NXCD, r = nwg % NXCD, xcd = wgid % NXCD, off = wgid / NXCD; wgid = (xcd < r ? xcd * (q + 1) : r * (q + 1) + (xcd - r) * q) + off; }
        const int nig = WGM * nN, gid = wgid / nig, fm = gid * WGM, gsz = (nM - fm) < WGM ? (nM - fm) : WGM;
        u.pm = fm + ((wgid % nig) % gsz); u.pn = (wgid % nig) / gsz; u.arow = u.pm * BM; u.aux = 0; return true;
    }
};
struct UpOrder {
    int G, c;
    __device__ bool next(int i, Unit& u) const {
        const long L = (long)i * G + c; if (L >= UP_UNITS) return false;
        const int seq = (int)(L % 8), off = (int)(L / 8);
        const int nig = WGM * UP_NT, gid = off / nig, fm = gid * WGM, gsz = (UP_MT - fm) < WGM ? (UP_MT - fm) : WGM, rem = off % nig;
        u.pm = fm + rem % gsz; u.pn = rem / gsz;
        int t0 = u.pm * UP_TILE; if (t0 > SEQ - UP_TILE) t0 = SEQ - UP_TILE;
        u.arow = seq * SEQ + t0 - 2; u.aux = t0 - 2; return true;
    }
};

__device__ __forceinline__ unsigned cvt_pk_bf16(float lo, float hi) { unsigned r; asm volatile("v_cvt_pk_bf16_f32 %0, %1, %2" : "=v"(r) : "v"(lo), "v"(hi)); return r; }
__device__ __forceinline__ u32x4 pack8(const f32x4& v0, const f32x4& v1) { u32x4 w; w.x = cvt_pk_bf16(v0[0], v0[1]); w.y = cvt_pk_bf16(v0[2], v0[3]); w.z = cvt_pk_bf16(v1[0], v1[1]); w.w = cvt_pk_bf16(v1[2], v1[3]); return w; }
__device__ __forceinline__ float sigmoidf_(float v) { return __builtin_amdgcn_rcpf(1.0f + __builtin_amdgcn_exp2f(-v * LOG2E)); }
__device__ __forceinline__ float shx(float v, int m) { return __shfl_xor(v, m); }


struct EpiIn {
    static constexpr bool PERM = true;
    const float* rs0; const float* rope; const float* gbias;
    bf16_t *gq, *gk, *gv, *gg, *sq, *sk, *sv; float* la;
    __device__ __forceinline__ void operator()(f32x4 (&acc)[2][2][4][2], const Unit& u, int wr, int wc, int fr, int fq, PG8_LAS unsigned char*) const {
        asm volatile("" : "+v"(fr), "+v"(fq));
        const int pn = u.pn, cw = 32 * wc + 8 * fq, row0 = u.arow + wr * 64 + fr;
        if (pn == 4) {
            f32x4 bv[2][2];
#pragma unroll
            for (int bj = 0; bj < 2; ++bj)
#pragma unroll
                for (int n = 0; n < 2; ++n) bv[bj][n] = *(const f32x4*)(gbias + bj * HALF + cw + 4 * n);
#pragma unroll
            for (int ai = 0; ai < 2; ++ai)
#pragma unroll
                for (int m = 0; m < 4; ++m) { const int row = row0 + ai * HALF + m * 16; const float s = rs0[row];
#pragma unroll
                    for (int bj = 0; bj < 2; ++bj)
#pragma unroll
                        for (int n = 0; n < 2; ++n) { f32x4 v = acc[ai][bj][m][n] * s + bv[bj][n], o;
#pragma unroll
                            for (int e = 0; e < 4; ++e) { const float x = v[e], ex = __builtin_amdgcn_exp2f(-__builtin_fabsf(x) * LOG2E);
                                o[e] = (__builtin_fminf(x, 0.f) - __builtin_amdgcn_logf(1.0f + ex) * 0.6931471805599453f) * (1.0f / 16.0f); }
                            *(f32x4*)(la + (size_t)row * 256 + bj * HALF + cw + 4 * n) = o; } }
            return;
        }
        bf16_t* dst0; bf16_t* dst1; int ld; float sc = 1.f; bool rot0 = false, rot1 = false, silu = false;
        if (pn == 0) { dst0 = gq; dst1 = gq + HALF; ld = 256; sc = 0.125f; }
        else if (pn == 1) { dst0 = gk; dst1 = gk + HALF; ld = 256; }
        else if (pn <= 3) { dst0 = gv + (pn - 2) * 256; dst1 = dst0 + HALF; ld = 512; }
        else if (pn <= 6) { dst0 = gg + (pn - 5) * 256; dst1 = dst0 + HALF; ld = 512; silu = true; }
        else if (pn <= 8) { dst0 = sq + (pn - 7) * 256; dst1 = dst0 + HALF; ld = 512; rot0 = rot1 = true; sc = QSCALE; }
        else { dst0 = sk; dst1 = sv; ld = 128; rot0 = true; }
        const bool rw = (wc & 1) == 0;
        const float sgn = (fq == 0) ? -1.f : 1.f;
#pragma unroll
        for (int ai = 0; ai < 2; ++ai)
#pragma unroll
            for (int m = 0; m < 4; ++m) { const int row = row0 + ai * HALF + m * 16; const float s = rs0[row];
                f32x4 c0, c1, s0, s1;
                if (rot0 && rw) { const float* rp = rope + (size_t)row * 16; c0 = *(const f32x4*)(rp); c1 = *(const f32x4*)(rp + 4); s0 = *(const f32x4*)(rp + 8); s1 = *(const f32x4*)(rp + 12); }
#pragma unroll
                for (int bj = 0; bj < 2; ++bj) { f32x4 v0 = acc[ai][bj][m][0] * s, v1 = acc[ai][bj][m][1] * s;
                    if (silu) {
#pragma unroll
                        for (int e = 0; e < 4; ++e) { v0[e] = v0[e] * sigmoidf_(v0[e]); v1[e] = v1[e] * sigmoidf_(v1[e]); } }
                    if ((bj == 0 ? rot0 : rot1) && rw) { f32x4 p0, p1;
#pragma unroll
                        for (int e = 0; e < 4; ++e) { p0[e] = shx(v0[e], 16); p1[e] = shx(v1[e], 16); }
                        if (fq < 2) { v0 = v0 * c0 + (p0 * s0) * sgn; v1 = v1 * c1 + (p1 * s1) * sgn; } }
                    v0 = v0 * sc; v1 = v1 * sc;
                    *(u32x4*)((bj == 0 ? dst0 : dst1) + (size_t)row * ld + cw) = pack8(v0, v1); } }
    }
};

struct EpiY {
    static constexpr bool PERM = true;
    bf16_t* y; float* part;
    __device__ __forceinline__ void operator()(f32x4 (&acc)[2][2][4][2], const Unit& u, int wr, int wc, int fr, int fq, PG8_LAS unsigned char*) const {
        asm volatile("" : "+v"(fr), "+v"(fq));
        const int row0 = u.arow + wr * 64 + fr, col0 = u.pn * BM + wc * 32 + 8 * fq;
#pragma unroll
        for (int ai = 0; ai < 2; ++ai)
#pragma unroll
            for (int m = 0; m < 4; ++m) { const int row = row0 + ai * HALF + m * 16; float ss = 0.f;
#pragma unroll
                for (int bj = 0; bj < 2; ++bj) { const f32x4 v0 = acc[ai][bj][m][0], v1 = acc[ai][bj][m][1];
                    ss += (v0[0] * v0[0] + v0[1] * v0[1]) + (v0[2] * v0[2] + v0[3] * v0[3]) + (v1[0] * v1[0] + v1[1] * v1[1]) + (v1[2] * v1[2] + v1[3] * v1[3]);
                    *(u32x4*)(y + (size_t)row * DM + col0 + bj * HALF) = pack8(v0, v1); }
                ss += shx(ss, 16); ss += shx(ss, 32);
                if (fq == 0) part[(size_t)row * 16 + u.pn * 4 + wc] = ss; }
    }
};

struct EpiUp {
    static constexpr bool PERM = true;
    bf16_t* act; const float* rs1; const float* cw; const float* cb;
    __device__ __forceinline__ void operator()(f32x4 (&acc)[2][2][4][2], const Unit& u, int wr, int wc, int fr, int fq, PG8_LAS unsigned char* xl) const {
        asm volatile("" : "+v"(fr), "+v"(fq));
#pragma unroll
        for (int ai = 0; ai < 2; ++ai)
#pragma unroll
            for (int m = 0; m < 4; ++m) { const float s = rs1[u.arow + ai * HALF + wr * 64 + m * 16 + fr];
#pragma unroll
                for (int bj = 0; bj < 2; ++bj)
#pragma unroll
                    for (int n = 0; n < 2; ++n) acc[ai][bj][m][n] = acc[ai][bj][m][n] * s; }
        asm volatile("" ::: "memory");
        PG8_LAS f32x4* X = (PG8_LAS f32x4*)xl;
        if (fr >= 14) {
#pragma unroll
            for (int ai = 0; ai < 2; ++ai)
#pragma unroll
                for (int bj = 0; bj < 2; ++bj)
#pragma unroll
                    for (int n = 0; n < 2; ++n) X[((((ai * 2 + wr) * 4 + wc) * 2 + (fr - 14)) * 4 + fq) * 4 + bj * 2 + n] = acc[ai][bj][3][n];
        }
        asm volatile("s_waitcnt lgkmcnt(0)" ::: "memory"); __builtin_amdgcn_s_barrier(); asm volatile("" ::: "memory");
#define DPPF(v, ctrl) __int_as_float(__builtin_amdgcn_update_dpp(0, __float_as_int(v), (ctrl), 0xf, 0xf, true))
        const int colv = u.pn * HALF + wc * 32 + 8 * fq;
        const f32x4 zero4 = (f32x4){0.f, 0.f, 0.f, 0.f};
#pragma unroll
        for (int bj = 0; bj < 2; ++bj) {
#pragma unroll
            for (int n = 0; n < 2; ++n) { const int c = bj * DFF + colv + 4 * n;
                const f32x4 pb = *(const f32x4*)(cb + c), p0 = *(const f32x4*)(cw + c), p1 = *(const f32x4*)(cw + NUP + c), p2 = *(const f32x4*)(cw + 2 * NUP + c);
#pragma unroll
                for (int ai = 0; ai < 2; ++ai) {
                    const bool has = !(wr == 0 && ai == 0);
                    const int pai = (wr == 1) ? ai : ai - 1, pwr = (wr == 1) ? 0 : 1;
                    f32x4 prev = zero4;
                    if (has && fr >= 14) prev = X[((((pai * 2 + pwr) * 4 + wc) * 2 + (fr - 14)) * 4 + fq) * 4 + bj * 2 + n];
#pragma unroll
                    for (int m = 0; m < 4; ++m) {
                        const f32x4 cur = acc[ai][bj][m][n]; f32x4 q1, q2;
#pragma unroll
                        for (int e = 0; e < 4; ++e) { q1[e] = DPPF(cur[e], 0x111) + DPPF(prev[e], 0x10F); q2[e] = DPPF(cur[e], 0x112) + DPPF(prev[e], 0x10E); }
                        const int t = u.aux + ai * HALF + wr * 64 + m * 16 + fr;
                        if (t < 1) q1 = zero4;
                        if (t < 2) q2 = zero4;
                        acc[ai][bj][m][n] = pb + p0 * q2 + p1 * q1 + p2 * cur;
                        asm volatile("" : "+v"(acc[ai][bj][m][n]));
                        prev = cur;
                    }
                    asm volatile("" ::: "memory");
                }
            }
        }
#undef DPPF
#pragma unroll
        for (int ai = 0; ai < 2; ++ai)
#pragma unroll
            for (int m = 0; m < 4; ++m) { const int lr = ai * HALF + wr * 64 + m * 16 + fr;
                f32x4 o[2];
#pragma unroll
                for (int n = 0; n < 2; ++n)
#pragma unroll
                    for (int e = 0; e < 4; ++e) { const float g = acc[ai][1][m][n][e], v = acc[ai][0][m][n][e];
                        const float z = 0.7978845608028654f * (g + 0.044715f * g * g * g);
                        o[n][e] = g * __builtin_amdgcn_rcpf(1.0f + __builtin_amdgcn_exp2f(-2.0f * LOG2E * z)) * v; }
                if (lr >= 2) *(u32x4*)(act + (size_t)(u.arow + lr) * DFF + colv) = pack8(o[0], o[1]);
                asm volatile("" ::: "memory"); }
    }
};

template <class Epi, class Sched, bool ALIGN_EPI = true, bool SP2 = true>
__device__ __forceinline__ void gemm_phase(PG8_LAS unsigned char* lds, const Gemm g, const Sched& S, const Epi& E) {
    const int tid = threadIdx.x, wid = __builtin_amdgcn_readfirstlane(tid >> 6), lane = tid & 63, wr = wid >> 2, wc = wid & 3, fr = lane & 15, fq = lane >> 4;
    const int K = g.K, nt = K / BK;
    unsigned voffA[2], voffB[2];
#pragma unroll
    for (int i = 0; i < 2; ++i) { int R, C; stage_rc(tid * 16 + i * 8192, R, C); const int Rb = Epi::PERM ? ((R & ~31) + perm32(R & 31)) : R;
        voffA[i] = (unsigned)(R * K + C) * 2u; voffB[i] = (unsigned)(Rb * K + C) * 2u; }
    const size_t kstep = (size_t)(BK * 2);
    const size_t hstep = (size_t)HALF * K * 2;
    const size_t tstep = 2 * hstep;
    const long rstep = (long)K * 2;
    const unsigned ldsw = (unsigned)wid * 1024u;
    const int aoff = lds_byte(wr * 64 + fr, fq * 8), boff = lds_byte(wc * 32 + fr, fq * 8);
#define PG8_SA(b, h) (((b) * 2 + (h)) * HTB)
#define PG8_SB(b, h) ((4 + (b) * 2 + (h)) * HTB)
#define PG8_STAGE(bufoff, gbase, voff) do { _Pragma("unroll") for (int _i = 0; _i < 2; ++_i) \
        __builtin_amdgcn_global_load_lds((const unsigned*)((const char*)(gbase) + (voff)[_i]), (PG8_LAS unsigned*)(lds + (bufoff) + ldsw + _i * 8192), 16, 0, 0); } while (0)
#define PG8_LDA(dst, b, h) do { _Pragma("unroll") for (int m = 0; m < 4; ++m) _Pragma("unroll") for (int k = 0; k < 2; ++k) dst[m][k] = *(const PG8_LAS bf16x8*)(lds + PG8_SA(b, h) + aoff + m * 2048 + k * 1024); } while (0)
#define PG8_LDB(dst, b, h) do { _Pragma("unroll") for (int n = 0; n < 2; ++n) _Pragma("unroll") for (int k = 0; k < 2; ++k) dst[n][k] = *(const PG8_LAS bf16x8*)(lds + PG8_SB(b, h) + boff + n * 2048 + k * 1024); } while (0)
#define PG8_MMA(ai, bj, At, Bt) do { __builtin_amdgcn_s_setprio(1); _Pragma("unroll") for (int m = 0; m < 4; ++m) _Pragma("unroll") for (int n = 0; n < 2; ++n) _Pragma("unroll") for (int k = 0; k < 2; ++k) \
        acc[ai][bj][m][n] = __builtin_amdgcn_mfma_f32_16x16x32_bf16(Bt[n][k], At[m][k], acc[ai][bj][m][n], 0, 0, 0); __builtin_amdgcn_s_setprio(0); } while (0)
#define PG8_WAIT_V(n) asm volatile("s_waitcnt vmcnt(" #n ")" ::: "memory")
#define PG8_WAIT_L(n) asm volatile("s_waitcnt lgkmcnt(" #n ")" ::: "memory")
#define PG8_BAR __builtin_amdgcn_s_barrier()
#define PG8_SCHED __builtin_amdgcn_sched_barrier(0)
    Unit cur, nxt; int ui = 0;
    if (!S.next(0, cur)) return;
    f32x4 acc[2][2][4][2];
#pragma unroll
    for (int a = 0; a < 2; ++a)
#pragma unroll
        for (int b = 0; b < 2; ++b)
#pragma unroll
            for (int m = 0; m < 4; ++m)
#pragma unroll
                for (int n = 0; n < 2; ++n) acc[a][b][m][n] = (f32x4){0.f, 0.f, 0.f, 0.f};
    bf16x8 At[4][2], B0[2][2], B1[2][2];
    const char* cA = (const char*)g.A + (long)cur.arow * rstep; const char* cB = (const char*)g.Bt + (size_t)cur.pn * tstep;
    if constexpr (SP2) {
        PG8_STAGE(PG8_SB(0, 0), cB, voffB); PG8_STAGE(PG8_SB(0, 1), cB + hstep, voffB); PG8_STAGE(PG8_SA(0, 0), cA, voffA); PG8_STAGE(PG8_SA(0, 1), cA + hstep, voffA);
        if (wr == 1) PG8_BAR;
        PG8_WAIT_V(2); PG8_BAR;
        PG8_STAGE(PG8_SB(1, 0), cB + kstep, voffB); PG8_STAGE(PG8_SA(1, 0), cA + kstep, voffA); PG8_STAGE(PG8_SB(1, 1), cB + hstep + kstep, voffB);
        PG8_WAIT_V(6); PG8_BAR;
    } else {
        PG8_STAGE(PG8_SB(0, 0), cB, voffB); PG8_STAGE(PG8_SA(0, 0), cA, voffA); PG8_STAGE(PG8_SB(0, 1), cB + hstep, voffB); PG8_STAGE(PG8_SA(0, 1), cA + hstep, voffA);
        if (wr == 1) PG8_BAR;
        PG8_WAIT_V(4); PG8_BAR;
        PG8_STAGE(PG8_SB(1, 0), cB + kstep, voffB); PG8_STAGE(PG8_SA(1, 0), cA + kstep, voffA); PG8_STAGE(PG8_SB(1, 1), cB + hstep + kstep, voffB);
        PG8_WAIT_V(6); PG8_BAR;
    }
    for (;;) {
        const bool has_next = S.next(ui + 1, nxt);
        const char* nA = has_next ? (const char*)g.A + (long)nxt.arow * rstep : cA; const char* nB = has_next ? (const char*)g.Bt + (size_t)nxt.pn * tstep : cB;
        for (int t = 0; t < nt; t += 2) {
            const bool last = (t == nt - 2);
            const char* a1 = cA + (size_t)(t + 1) * kstep;
            const char* a2 = last ? nA : cA + (size_t)(t + 2) * kstep; const char* b2 = last ? nB : cB + (size_t)(t + 2) * kstep;
            const char* a3 = a2 + kstep; const char* b3 = b2 + kstep;
            if constexpr (SP2) {
            PG8_LDB(B0, 0, 0); PG8_LDB(B1, 0, 1); PG8_SCHED; PG8_LDA(At, 0, 0); PG8_STAGE(PG8_SA(1, 1), a1 + hstep, voffA);
            PG8_WAIT_V(8); PG8_WAIT_L(0); PG8_BAR; PG8_MMA(0, 0, At, B0); PG8_MMA(0, 1, At, B1); PG8_BAR; PG8_SCHED;
            PG8_LDA(At, 0, 1); PG8_STAGE(PG8_SB(0, 0), b2, voffB); PG8_STAGE(PG8_SB(0, 1), b2 + hstep, voffB); PG8_STAGE(PG8_SA(0, 0), a2, voffA);
            PG8_WAIT_V(8); PG8_WAIT_L(0); PG8_BAR; PG8_MMA(1, 0, At, B0); PG8_MMA(1, 1, At, B1); PG8_BAR; PG8_SCHED;
            PG8_LDB(B0, 1, 0); PG8_LDB(B1, 1, 1); PG8_SCHED; PG8_LDA(At, 1, 0); PG8_STAGE(PG8_SA(0, 1), a2 + hstep, voffA);
            PG8_WAIT_V(8); PG8_WAIT_L(0); PG8_BAR; PG8_MMA(0, 0, At, B0); PG8_MMA(0, 1, At, B1); PG8_BAR; PG8_SCHED;
            PG8_LDA(At, 1, 1); PG8_STAGE(PG8_SB(1, 0), b3, voffB); PG8_STAGE(PG8_SB(1, 1), b3 + hstep, voffB); PG8_STAGE(PG8_SA(1, 0), a3, voffA);
            PG8_WAIT_V(8); PG8_WAIT_L(0); PG8_BAR; PG8_MMA(1, 0, At, B0); PG8_MMA(1, 1, At, B1); PG8_BAR; PG8_SCHED;
            } else {
            PG8_LDB(B0, 0, 0); PG8_SCHED; PG8_LDA(At, 0, 0); PG8_STAGE(PG8_SA(1, 1), a1 + hstep, voffA);
            PG8_WAIT_L(8); PG8_BAR; PG8_WAIT_L(0); PG8_MMA(0, 0, At, B0); PG8_BAR; PG8_SCHED;
            PG8_LDB(B1, 0, 1); PG8_STAGE(PG8_SB(0, 0), b2, voffB);
            PG8_BAR; PG8_WAIT_L(0); PG8_MMA(0, 1, At, B1); PG8_BAR;
            PG8_LDA(At, 0, 1); PG8_STAGE(PG8_SA(0, 0), a2, voffA);
            PG8_BAR; PG8_WAIT_L(0); PG8_MMA(1, 0, At, B0); PG8_BAR; PG8_SCHED;
            PG8_STAGE(PG8_SB(0, 1), b2 + hstep, voffB);
            PG8_WAIT_V(6); PG8_BAR; PG8_MMA(1, 1, At, B1); PG8_BAR;
            PG8_LDB(B0, 1, 0); PG8_SCHED; PG8_LDA(At, 1, 0); PG8_STAGE(PG8_SA(0, 1), a2 + hstep, voffA);
            PG8_WAIT_L(8); PG8_BAR; PG8_WAIT_L(0); PG8_MMA(0, 0, At, B0); PG8_BAR; PG8_SCHED;
            PG8_LDB(B1, 1, 1); PG8_STAGE(PG8_SB(1, 0), b3, voffB);
            PG8_BAR; PG8_WAIT_L(0); PG8_MMA(0, 1, At, B1); PG8_BAR;
            PG8_LDA(At, 1, 1); PG8_STAGE(PG8_SA(1, 0), a3, voffA);
            PG8_BAR; PG8_WAIT_L(0); PG8_MMA(1, 0, At, B0); PG8_BAR; PG8_SCHED;
            PG8_STAGE(PG8_SB(1, 1), b3 + hstep, voffB);
            PG8_WAIT_V(6); PG8_BAR; PG8_MMA(1, 1, At, B1); PG8_BAR;
            }
        }
        if constexpr (ALIGN_EPI) { if (wr == 0) PG8_BAR; }
        E(acc, cur, wr, wc, fr, fq, lds + STAGE_BYTES);
        if (!has_next) break;
#pragma unroll
        for (int a = 0; a < 2; ++a)
#pragma unroll
            for (int b = 0; b < 2; ++b)
#pragma unroll
                for (int m = 0; m < 4; ++m)
#pragma unroll
                    for (int n = 0; n < 2; ++n) acc[a][b][m][n] = (f32x4){0.f, 0.f, 0.f, 0.f};
        cur = nxt; cA = nA; cB = nB; ++ui;
        if constexpr (ALIGN_EPI) { if (wr == 1) PG8_BAR; }
    }
    PG8_WAIT_V(0);
    if constexpr (!ALIGN_EPI) { if (wr == 0) PG8_BAR; }
    PG8_BAR;
#undef PG8_SA
#undef PG8_SB
#undef PG8_STAGE
#undef PG8_LDA
#undef PG8_LDB
#undef PG8_MMA
#undef PG8_WAIT_V
#undef PG8_WAIT_L
#undef PG8_BAR
#undef PG8_SCHED
}
}

constexpr int NWAVES = 8, NTHREADS = NWAVES * 64;
constexpr int LDS_BYTES = 147456;
#define LAS __attribute__((address_space(3)))
typedef unsigned short bf16;
typedef unsigned v4u __attribute__((ext_vector_type(4)));
typedef unsigned v2u __attribute__((ext_vector_type(2)));
typedef float f32x4 __attribute__((ext_vector_type(4)));
#define LDS_WAIT() asm volatile("s_waitcnt lgkmcnt(0)" ::: "memory")
__device__ __forceinline__ unsigned f2bf(float f) { unsigned u = __builtin_bit_cast(unsigned, f); return (u + 0x7fffu + ((u >> 16) & 1u)) >> 16; }
__device__ __forceinline__ unsigned pk2(float lo, float hi) { return f2bf(lo) | (f2bf(hi) << 16); }
__device__ __forceinline__ float bflo(unsigned w) { return __uint_as_float(w << 16); }
__device__ __forceinline__ float bfhi(unsigned w) { return __uint_as_float(w & 0xffff0000u); }
__device__ __forceinline__ float wave_sum(float v) {
#pragma unroll
    for (int o = 1; o < 64; o <<= 1) v += __shfl_xor(v, o);
    return v;
}


typedef short bf16x8 __attribute__((ext_vector_type(8)));
typedef short s16x4 __attribute__((ext_vector_type(4)));
typedef float f32x16 __attribute__((ext_vector_type(16)));
#define MFMA32(a, b, c) __builtin_amdgcn_mfma_f32_32x32x16_bf16((a), (b), (c), 0, 0, 0)
__device__ __forceinline__ int crow(int reg, int h) { return (reg & 3) + 8 * (reg >> 2) + 4 * h; }
__device__ __forceinline__ bf16x8 rowfrag(const LAS unsigned char* tile, int stride, int row, int k0) { return *(const LAS bf16x8*)(tile + row * stride + k0 * 2); }
__device__ __forceinline__ bf16x8 trfrag(const LAS unsigned char* tile, int stride, int k0, int col0, int lane, bool perm) {
    const int g = lane >> 4, i = lane & 15, hh = g >> 1;
    const int rowA = k0 + (perm ? 4 * hh : 8 * hh) + (i >> 2), rowB = rowA + (perm ? 8 : 4), col = col0 + 16 * (g & 1) + 4 * (i & 3);
    const s16x4 lo = __builtin_bit_cast(s16x4, __builtin_amdgcn_ds_read_tr16_b64_v4i16((LAS s16x4*)(tile + rowA * stride + col * 2)));
    const s16x4 hi = __builtin_bit_cast(s16x4, __builtin_amdgcn_ds_read_tr16_b64_v4i16((LAS s16x4*)(tile + rowB * stride + col * 2)));
    return (bf16x8){lo[0], lo[1], lo[2], lo[3], hi[0], hi[1], hi[2], hi[3]};
}
typedef float f32x2_t __attribute__((ext_vector_type(2))); typedef __bf16 bf16x2_t __attribute__((ext_vector_type(2)));
__device__ __forceinline__ unsigned cvtpk_s(float lo, float hi) { f32x2_t v = {lo, hi}; bf16x2_t b = __builtin_convertvector(v, bf16x2_t); return __builtin_bit_cast(unsigned, b); }
__device__ __forceinline__ bf16x8 pack_acc8(const f32x16& x, int s) {
    v4u w; w.x = cvtpk_s(x[8 * s + 0], x[8 * s + 1]); w.y = cvtpk_s(x[8 * s + 2], x[8 * s + 3]); w.z = cvtpk_s(x[8 * s + 4], x[8 * s + 5]); w.w = cvtpk_s(x[8 * s + 6], x[8 * s + 7]);
    return __builtin_bit_cast(bf16x8, w);
}
__device__ __forceinline__ float bf2f(unsigned short h) { return __uint_as_float((unsigned)h << 16); }

constexpr int GL_T = 0;
constexpr int GL_QS = 2048, GL_KS = GL_QS + 64 * 144, GL_VT = GL_KS + 64 * 144, GL_OT = GL_VT + 64 * 272;
constexpr int GL_END = GL_OT + 64 * 528;
constexpr int SW_KS = 0, SW_VS = 256 * 144, SW_LS = 2 * 256 * 144, SW_END = SW_LS + 8 * 128;
static_assert(GL_END <= 131072 && SW_END <= 131072, "mixer LDS");

__device__ __forceinline__ void gla_prep(const float* LA, size_t row0, int h, int lane, int wave, LAS unsigned char* lds, float (&b)[8], float& blast) {
    LAS float* T = (LAS float*)(lds + GL_T);
    float run = 0.f;
#pragma unroll
    for (int i = 0; i < 8; ++i) { run += LA[(row0 + 8 * wave + i) * 256 + h * 64 + lane]; b[i] = run; }
    T[wave * 64 + lane] = run;
    __syncthreads();
    float off = 0.f, tot = 0.f;
#pragma unroll
    for (int g = 0; g < 8; ++g) { const float t = T[g * 64 + lane]; tot += t; off += (g < wave) ? t : 0.f; }
#pragma unroll
    for (int i = 0; i < 8; ++i) b[i] += off;
    blast = tot;
}


#define GAS __attribute__((address_space(1)))
#define XB_TMO      128
#define XB_XCNT(j)  (256  + 64 * (j))
#define XB_XSUB(j)  (1280 + 64 * (j))
#define XB_XGEN(j)  (2304 + 64 * (j))
#define XB_TOP      3328
#define XB_TOPGEN   3392
#define XCD_BAR_WORDS 3456
#define XB_SPIN_CAP (1u << 18)
__device__ __forceinline__ unsigned xb_ld(unsigned* p)              { return __hip_atomic_load(p, __ATOMIC_RELAXED, __HIP_MEMORY_SCOPE_AGENT); }
__device__ __forceinline__ unsigned xb_add(unsigned* p, unsigned v) { return __hip_atomic_fetch_add(p, v, __ATOMIC_RELAXED, __HIP_MEMORY_SCOPE_AGENT); }
__device__ __forceinline__ unsigned xb_xcc_id() { return (unsigned)__builtin_amdgcn_s_getreg((3 << 11) | 20) & 0xFu; }
#define XB_SPIN(cond, bar) do { unsigned _sp = 0; while (cond) { __builtin_amdgcn_s_sleep(1); \
    if ((++_sp & 255u) == 0u) { if (xb_ld(&(bar)[XB_TMO])) break; if (_sp > XB_SPIN_CAP) { atomicAdd(&(bar)[XB_TMO], 1u); break; } } } } while (0)
struct XcdBarrier { unsigned* bar; unsigned x; volatile LAS unsigned* st; };
__device__ __forceinline__ XcdBarrier xcd_barrier_post(unsigned* bar, volatile LAS unsigned* st) {
    XcdBarrier b; b.bar = bar; b.x = xb_xcc_id(); b.st = st;
    if (threadIdx.x == 0) (void)xb_add(&bar[XB_XCNT(b.x)], 1u);
    return b;
}
__device__ __forceinline__ void xcd_barrier_complete(unsigned* bar, unsigned x, unsigned& nloc, unsigned& nx) {
    const unsigned Gn = gridDim.x * gridDim.y * gridDim.z;
    unsigned sum, cnt, mine, sp = 0u;
    for (;;) {
        sum = 0u; cnt = 0u; mine = 0u;
#pragma unroll
        for (unsigned j = 0; j < 16; ++j) { const unsigned c = xb_ld(&bar[XB_XCNT(j)]); sum += c; cnt += (c > 0u) ? 1u : 0u; mine = (j == x) ? c : mine; }
        if (sum == Gn) break;
        __builtin_amdgcn_s_sleep(1);
        if ((++sp & 255u) == 0u) { if (xb_ld(&bar[XB_TMO])) break; if (sp > XB_SPIN_CAP) { atomicAdd(&bar[XB_TMO], 1u); break; } }
    }
    nloc = mine > 0u ? mine : 1u; nx = cnt > 0u ? cnt : 1u;
}
__device__ __forceinline__ void xcd_barrier(const XcdBarrier& b) {
    asm volatile("s_waitcnt vmcnt(0)" ::: "memory");
    __syncthreads();
    if (threadIdx.x == 0) {
        unsigned* bar = b.bar;
        __builtin_amdgcn_s_waitcnt(0);
        unsigned nloc = b.st[0], nx = b.st[1];
        if (nloc == 0u) { xcd_barrier_complete(bar, b.x, nloc, nx); b.st[0] = nloc; b.st[1] = nx; }
        const unsigned old = xb_add(&bar[XB_XSUB(b.x)], 1u);
        const unsigned gen = old / nloc;
        if (old + 1u == (gen + 1u) * nloc) {
            __builtin_amdgcn_fence(__ATOMIC_RELEASE, "agent");
            asm volatile("s_waitcnt vmcnt(0)" ::: "memory");
            const unsigned og = xb_add(&bar[XB_TOP], 1u);
            const unsigned tg = og / nx;
            if (og + 1u == (tg + 1u) * nx) xb_add(&bar[XB_TOPGEN], 1u);
            else XB_SPIN(xb_ld(&bar[XB_TOPGEN]) == tg, bar);
            __builtin_amdgcn_fence(__ATOMIC_ACQUIRE, "agent");
            xb_add(&bar[XB_XGEN(b.x)], 1u);
            asm volatile("s_waitcnt vmcnt(0)" ::: "memory");
        } else {
            XB_SPIN(xb_ld(&bar[XB_XGEN(b.x)]) == gen, bar);
            __builtin_amdgcn_fence(__ATOMIC_ACQUIRE, "agent");
            asm volatile("s_waitcnt vmcnt(0)" ::: "memory");
        }
    }
    __syncthreads();
}
constexpr int CW_BAR = 4096;
constexpr int LDS_MISC_OFF = 131072 + 12288;

struct Args {
    const float* x; const int* pos; const float* g_pre; const float* w_in; const float* gate_up; const float* gate_bias; const float* g_gla; const float* sinks;
    const float* w_out; const float* g_postmix; const float* g_preffn; const float* w_up; const float* conv_w; const float* conv_b; const float* w_down; const float* g_postffn;
    float* out; unsigned char* ws; int ph_lo, ph_hi;
};

__device__ __forceinline__ void p0_transpose_item(const float* W, int ldw, int col0, int K, bf16* WT, int mode, int rowoff, const float* gain, LAS float* scr, int kb, int nb, int lane) {
    const int k0 = 64 * kb, n0 = 32 * nb;
#pragma unroll 8
    for (int i = 0; i < 32; ++i) { const int kk = 2 * i + (lane >> 5); float v = W[(size_t)(k0 + kk) * ldw + col0 + n0 + (lane & 31)]; if (gain) v *= gain[k0 + kk]; scr[kk * 33 + (lane & 31)] = v; }
    LDS_WAIT(); asm volatile("" ::: "memory");
    const int c = lane & 7;
#pragma unroll
    for (int j = 0; j < 4; ++j) { const int n = (lane >> 3) + 8 * j; const LAS float* s = scr + (8 * c) * 33 + n;
        v4u o; o.x = pk2(s[0 * 33], s[1 * 33]); o.y = pk2(s[2 * 33], s[3 * 33]); o.z = pk2(s[4 * 33], s[5 * 33]); o.w = pk2(s[6 * 33], s[7 * 33]);
        const int nn = n0 + n; int dr;
        if (mode == 0) dr = rowoff + nn;
        else dr = (nn < DFF) ? ((nn >> 7) * 256 + (nn & 127)) : (((nn - DFF) >> 7) * 256 + 128 + ((nn - DFF) & 127));
        *(v4u*)(WT + (size_t)dr * K + k0 + 8 * c) = o; }
    LDS_WAIT(); asm volatile("" ::: "memory");
}

__global__ void __launch_bounds__(NTHREADS, 2) fwd(Args a) {
    extern __shared__ __attribute__((aligned(16))) unsigned char lds_raw[];
    LAS unsigned char* lds = (LAS unsigned char*)lds_raw;
    const int tid = threadIdx.x, lane = tid & 63, wave = __builtin_amdgcn_readfirstlane(tid >> 6);
    const int G = gridDim.x, bid = blockIdx.x;
    const int gw = bid * NWAVES + wave, NGW = G * NWAVES;
    unsigned char* ws = a.ws;
    bf16* Wt_in = (bf16*)(ws + WS_WIN); bf16* Wt_out = (bf16*)(ws + WS_WOUT); bf16* Wt_up = (bf16*)(ws + WS_WUP); bf16* Wt_dn = (bf16*)(ws + WS_WDN);
    float* rope = (float*)(ws + WS_ROPE); float* rs0 = (float*)(ws + WS_RS0); float* rs1 = (float*)(ws + WS_RS1); float* part = (float*)(ws + WS_PART);
    bf16* XB = (bf16*)(ws + WS_XB); bf16* Y = (bf16*)(ws + WS_XB);
    bf16* GQ = (bf16*)(ws + WS_GQ); bf16* GK = (bf16*)(ws + WS_GK); bf16* GV = (bf16*)(ws + WS_GV); float* LA = (float*)(ws + WS_LA); bf16* GG = (bf16*)(ws + WS_GG);
    bf16* SQ = (bf16*)(ws + WS_SQ); bf16* SK = (bf16*)(ws + WS_SK); bf16* SV = (bf16*)(ws + WS_SV);
    bf16* ACT = (bf16*)(ws + WS_ACT); float* UT = (float*)(ws + WS_U); bf16* ST = (bf16*)(ws + WS_S); bf16* MIX = (bf16*)(ws + WS_MIX); bf16* X1B = (bf16*)(ws + WS_X1B);
    const int lo = a.ph_lo, hi = a.ph_hi;
#if MK_ONE_LAUNCH
    if (tid < 64) ((LAS unsigned*)(lds + LDS_MISC_OFF))[tid] = 0u;
    __syncthreads();
    const XcdBarrier xbar = xcd_barrier_post((unsigned*)(ws + WS_CTL) + CW_BAR, (volatile LAS unsigned*)(lds + LDS_MISC_OFF));
#endif
#ifndef PH_MASK
#define PH_MASK 0x3ff
#endif
#define IN(k) (((PH_MASK >> (k)) & 1) && lo <= (k) && (k) < hi)
#define BOTH(k) (IN(k) && IN((k) + 1))
#if MK_ONE_LAUNCH
#define GRID_BAR() xcd_barrier(xbar)
#define GRID_BAR_CG() cg::this_grid().sync()
#else
#define GRID_BAR() do { } while (0)
#define GRID_BAR_CG() do { } while (0)
#endif

    if (IN(0)) {
        LAS float* scr = (LAS float*)(lds + wave * 16384);
        constexpr int I_A = 16 * 32, I_B = 16 * 40, I_O = 16 * 32, I_U = 16 * 176, I_D = 44 * 32;
        constexpr int NITEMS = I_A + I_B + I_O + I_U + I_D;
        for (int it = gw; it < NITEMS; it += NGW) {
            int r = it;
            if (r < I_A) { p0_transpose_item(a.w_in, IN_W, 0, DM, Wt_in, 0, 0, a.g_pre, scr, r / 32, r % 32, lane); continue; } r -= I_A;
            if (r < I_B) { p0_transpose_item(a.w_in, IN_W, 1040, DM, Wt_in, 0, 1280, a.g_pre, scr, r / 40, r % 40, lane); continue; } r -= I_B;
            if (r < I_O) { p0_transpose_item(a.w_out, DM, 0, DM, Wt_out, 0, 0, nullptr, scr, r / 32, r % 32, lane); continue; } r -= I_O;
            if (r < I_U) { p0_transpose_item(a.w_up, NUP, 0, DM, Wt_up, 1, 0, a.g_preffn, scr, r / 176, r % 176, lane); continue; } r -= I_U;
            p0_transpose_item(a.w_down, DM, 0, DFF, Wt_dn, 0, 0, nullptr, scr, r / 32, r % 32, lane);
        }
        for (int idx = bid * NTHREADS + tid; idx < 256 * DM; idx += G * NTHREADS) { const int j = idx >> 10, k = idx & 1023;
            const float* wr_ = a.w_in + (size_t)k * IN_W + 1024; float s = 0.f;
#pragma unroll
            for (int r = 0; r < 16; ++r) s += wr_[r] * a.gate_up[r * 256 + j];
            Wt_in[(size_t)(1024 + j) * DM + k] = (bf16)f2bf(s * a.g_pre[k]); }
        for (int idx = bid * NTHREADS + tid; idx < M * 8; idx += G * NTHREADS) { const int row = idx >> 3, i = idx & 7;
            const float invf[8] = {1.0f, 0.1939227432012558f, 0.03760603070259094f, 0.007292664609849453f, 0.0014142135623842478f, 0.00027424818836152554f, 5.318296098266728e-05f, 1.0313386155758053e-05f};
            float inv = invf[0];
#pragma unroll
            for (int q = 1; q < 8; ++q) inv = (i == q) ? invf[q] : inv;
            const float ang = (float)a.pos[row] * inv;
            const double rev = (double)ang * 0.15915494309189535; const float fr_ = (float)(rev - __builtin_floor(rev));
            rope[(size_t)row * 16 + i] = __builtin_amdgcn_cosf(fr_); rope[(size_t)row * 16 + 8 + i] = __builtin_amdgcn_sinf(fr_); }
        for (int m = gw; m < M; m += NGW) { const f32x4* xr = (const f32x4*)(a.x + (size_t)m * DM) + lane; f32x4 v[4]; float s = 0.f;
#pragma unroll
            for (int j = 0; j < 4; ++j) { v[j] = xr[64 * j]; s += (v[j].x * v[j].x + v[j].y * v[j].y) + (v[j].z * v[j].z + v[j].w * v[j].w); }
            s = wave_sum(s); if (lane == 0) rs0[m] = 1.0f / sqrtf(s * (1.0f / DM) + EPS);
            v2u* o8 = (v2u*)(XB + (size_t)m * DM) + lane;
#pragma unroll
            for (int j = 0; j < 4; ++j) { v2u w; w.x = pk2(v[j].x, v[j].y); w.y = pk2(v[j].z, v[j].w); o8[64 * j] = w; } }
        if (BOTH(0)) GRID_BAR_CG();
    }

    if (IN(1)) {
        pg8::Gemm g{XB, Wt_in, DM}; pg8::StaticOrder S; S.init(M, NIN, G, bid);
        pg8::EpiIn E{rs0, rope, a.gate_bias, GQ, GK, GV, GG, SQ, SK, SV, LA};
        pg8::gemm_phase<pg8::EpiIn, pg8::StaticOrder>(lds, g, S, E);
        if (BOTH(1)) GRID_BAR();
    }

    if (IN(2)) {
        for (int unit = bid; unit < 4096; unit += G) { const int bh = unit >> 7, c = unit & 127, b_ = bh >> 2, h = bh & 3; const size_t row0 = (size_t)b_ * SEQ + c * 64;
            v4u vp[2];
#pragma unroll
            for (int i = 0; i < 2; ++i) { const int pc = tid + 512 * i, r = pc >> 4, cs = pc & 15; vp[i] = *(const v4u*)(GV + (row0 + r) * 512 + h * 128 + cs * 8); }
            unsigned short kk[8];
#pragma unroll
            for (int i = 0; i < 8; ++i) kk[i] = GK[(row0 + 8 * wave + i) * 256 + h * 64 + lane];
            float bb[8], blast; gla_prep(LA, row0, h, lane, wave, lds, bb, blast);
            { float e[8];
#pragma unroll
              for (int i = 0; i < 8; ++i) e[i] = bf2f(kk[i]) * __builtin_amdgcn_exp2f((blast - bb[i]) * LOG2E);
              v4u w; w.x = pk2(e[0], e[1]); w.y = pk2(e[2], e[3]); w.z = pk2(e[4], e[5]); w.w = pk2(e[6], e[7]);
              *(LAS v4u*)(lds + GL_KS + lane * 144 + wave * 16) = w; }
#pragma unroll
            for (int i = 0; i < 2; ++i) { const int pc = tid + 512 * i, r = pc >> 4, cs = pc & 15; *(LAS v4u*)(lds + GL_VT + r * 272 + cs * 16) = vp[i]; }
            if (wave == 0) ((float*)(ws + WS_GDEC))[(size_t)unit * 64 + lane] = __builtin_amdgcn_exp2f(blast * LOG2E);
            __syncthreads();
            { const int mb = wave >> 1, nb = wave & 1, r = lane & 31, hh = lane >> 5;
              f32x16 acc = {};
#pragma unroll
              for (int ks = 0; ks < 4; ++ks) { const bf16x8 A = trfrag(lds + GL_VT, 272, 16 * ks, 32 * mb, lane, false); const bf16x8 B = rowfrag(lds + GL_KS, 144, 32 * nb + r, 16 * ks + 8 * hh); acc = MFMA32(A, B, acc); }
              float* ut = UT + (size_t)unit * 8192 + 32 * nb + r;
#pragma unroll
              for (int reg = 0; reg < 16; ++reg) ut[(32 * mb + crow(reg, hh)) * 64] = acc[reg]; }
            __syncthreads();
        }
        for (int unit = bid; unit < BATCH * 2 * 64; unit += G) { const int qb = unit & 63, kvh = (unit >> 6) & 1, b_ = unit >> 7; const size_t rowq = (size_t)b_ * SEQ + qb * 128;
#pragma unroll
            for (int i = 0; i < 4; ++i) { const int pc = tid + 512 * i, key = pc >> 3, sg = pc & 7; v4u kv = (v4u){0u, 0u, 0u, 0u}, vv = kv;
                if (qb > 0 || key >= 128) { const size_t kr = rowq - 128 + key; kv = *(const v4u*)(SK + kr * 128 + kvh * 64 + sg * 8); vv = *(const v4u*)(SV + kr * 128 + kvh * 64 + sg * 8); }
                *(LAS v4u*)(lds + SW_KS + key * 144 + sg * 16) = kv; *(LAS v4u*)(lds + SW_VS + key * 144 + sg * 16) = vv; }
            __syncthreads();
            { const int hq = kvh * 4 + (wave >> 1), r = lane & 31, hh = lane >> 5; const float sink2 = a.sinks[hq] * LOG2E; LAS float* LS = (LAS float*)(lds + SW_LS) + wave * 32;
              for (int qt = 0; qt < 2; ++qt) { const int i0 = (wave & 1) * 64 + qt * 32, kt0 = i0 >> 5;
                  bf16x8 qf[4];
#pragma unroll
                  for (int ks = 0; ks < 4; ++ks) qf[ks] = *(const bf16x8*)(SQ + (rowq + i0 + r) * 512 + hq * 64 + 16 * ks + 8 * hh);
                  f32x16 X[5];
#pragma unroll
                  for (int t = 0; t < 5; ++t) { X[t] = (f32x16){};
#pragma unroll
                      for (int ks = 0; ks < 4; ++ks) X[t] = MFMA32(rowfrag(lds + SW_KS, 144, 32 * (kt0 + t) + r, 16 * ks + 8 * hh), qf[ks], X[t]); }
                  const int kq = 128 + i0 + r; float mx = sink2;
#pragma unroll
                  for (int t = 0; t < 5; ++t)
#pragma unroll
                      for (int reg = 0; reg < 16; ++reg) { const int kx = 32 * (kt0 + t) + crow(reg, hh); const bool ok = (kx <= kq) && (kx > kq - 128) && (qb > 0 || kx >= 128);
                          const float v = ok ? X[t][reg] : -INFINITY; X[t][reg] = v; mx = __builtin_fmaxf(mx, v); }
                  mx = __builtin_fmaxf(mx, __shfl_xor(mx, 32));
                  float l = 0.f;
#pragma unroll
                  for (int t = 0; t < 5; ++t)
#pragma unroll
                      for (int reg = 0; reg < 16; ++reg) { const float pv = __builtin_amdgcn_exp2f(X[t][reg] - mx); X[t][reg] = pv; l += pv; }
                  l += __shfl_xor(l, 32); l += __builtin_amdgcn_exp2f(sink2 - mx);
                  if (hh == 0) LS[r] = l;
                  f32x16 O0 = {}, O1 = {};
#pragma unroll
                  for (int t = 0; t < 5; ++t)
#pragma unroll
                      for (int s2 = 0; s2 < 2; ++s2) { const bf16x8 pa = pack_acc8(X[t], s2);
                          O0 = MFMA32(pa, trfrag(lds + SW_VS, 144, 32 * (kt0 + t) + 16 * s2, 0, lane, true), O0);
                          O1 = MFMA32(pa, trfrag(lds + SW_VS, 144, 32 * (kt0 + t) + 16 * s2, 32, lane, true), O1); }
                  LDS_WAIT();
                  bf16* op = MIX + (rowq + i0) * DM + 512 + hq * 64 + r;
#pragma unroll
                  for (int reg = 0; reg < 16; ++reg) { const int row = crow(reg, hh); const float rl = 1.0f / LS[row];
                      op[(size_t)row * DM] = (bf16)f2bf(O0[reg] * rl); op[(size_t)row * DM + 32] = (bf16)f2bf(O1[reg] * rl); }
                  LDS_WAIT();
              } }
            __syncthreads();
        }
        if (BOTH(2)) GRID_BAR();
    }

    if (IN(3)) {
        const float* GD = (const float*)(ws + WS_GDEC);
        for (int e = bid * NTHREADS + tid; e < 32 * 4096; e += G * NTHREADS) { const int bh = e >> 12, rem = e & 4095, dv = rem >> 5, dk = (rem & 31) * 2;
            float s0 = 0.f, s1 = 0.f;
            const size_t base = (size_t)bh * 128 * 8192 + dv * 64 + dk;
#pragma unroll 8
            for (int c = 0; c < 128; ++c) { const float2 u = *(const float2*)(UT + base + (size_t)c * 8192); const float2 g = *(const float2*)(GD + ((size_t)bh * 128 + c) * 64 + dk);
                *(unsigned*)(ST + base + (size_t)c * 8192) = pk2(s0, s1);
                s0 = g.x * s0 + u.x; s1 = g.y * s1 + u.y; } }
        if (BOTH(3)) GRID_BAR();
    }

    if (IN(4)) {
        for (int unit = bid; unit < 4096; unit += G) { const int bh = unit >> 7, c = unit & 127, b_ = bh >> 2, h = bh & 3; const size_t row0 = (size_t)b_ * SEQ + c * 64;
            v4u vp[2];
#pragma unroll
            for (int i = 0; i < 2; ++i) { const int pc = tid + 512 * i, r = pc >> 4, cs = pc & 15; vp[i] = *(const v4u*)(GV + (row0 + r) * 512 + h * 128 + cs * 8); }
            unsigned short kk[8], qq[8];
#pragma unroll
            for (int i = 0; i < 8; ++i) { kk[i] = GK[(row0 + 8 * wave + i) * 256 + h * 64 + lane]; qq[i] = GQ[(row0 + 8 * wave + i) * 256 + h * 64 + lane]; }
            float bb[8], blast; gla_prep(LA, row0, h, lane, wave, lds, bb, blast);
#pragma unroll
            for (int i = 0; i < 8; ++i) { const float ep = __builtin_amdgcn_exp2f(bb[i] * LOG2E), en = __builtin_amdgcn_exp2f(-bb[i] * LOG2E);
                *(LAS unsigned short*)(lds + GL_QS + (8 * wave + i) * 144 + lane * 2) = (unsigned short)f2bf(bf2f(qq[i]) * ep);
                *(LAS unsigned short*)(lds + GL_KS + (8 * wave + i) * 144 + lane * 2) = (unsigned short)f2bf(bf2f(kk[i]) * en); }
#pragma unroll
            for (int i = 0; i < 2; ++i) { const int pc = tid + 512 * i, r = pc >> 4, cs = pc & 15; *(LAS v4u*)(lds + GL_VT + r * 272 + cs * 16) = vp[i]; }
            __syncthreads();
            { const int ib = wave >> 2, nb = wave & 3, r = lane & 31, hh = lane >> 5;
              bf16x8 st[4];
#pragma unroll
              for (int ks = 0; ks < 4; ++ks) st[ks] = *(const bf16x8*)(ST + (size_t)unit * 8192 + (32 * nb + r) * 64 + 16 * ks + 8 * hh);
              f32x16 o = {};
              for (int jb = 0; jb <= ib; ++jb) { f32x16 X = {};
#pragma unroll
                  for (int ks = 0; ks < 4; ++ks) X = MFMA32(rowfrag(lds + GL_KS, 144, 32 * jb + r, 16 * ks + 8 * hh), rowfrag(lds + GL_QS, 144, 32 * ib + r, 16 * ks + 8 * hh), X);
                  if (jb == ib) {
#pragma unroll
                      for (int reg = 0; reg < 16; ++reg) X[reg] = (crow(reg, hh) > r) ? 0.f : X[reg]; }
#pragma unroll
                  for (int s2 = 0; s2 < 2; ++s2) o = MFMA32(pack_acc8(X, s2), trfrag(lds + GL_VT, 272, 32 * jb + 16 * s2, 32 * nb, lane, true), o); }
#pragma unroll
              for (int ks = 0; ks < 4; ++ks) o = MFMA32(rowfrag(lds + GL_QS, 144, 32 * ib + r, 16 * ks + 8 * hh), st[ks], o);
              LAS float* ot = (LAS float*)(lds + GL_OT) + 32 * nb + r;
#pragma unroll
              for (int reg = 0; reg < 16; ++reg) ot[(32 * ib + crow(reg, hh)) * 132] = o[reg]; }
            __syncthreads();
            { const int row = tid >> 3, sg = tid & 7; const LAS f32x4* op = (const LAS f32x4*)(lds + GL_OT + row * 528 + sg * 64);
              f32x4 ov[4]; float ss = 0.f;
#pragma unroll
              for (int q = 0; q < 4; ++q) { ov[q] = op[q]; ss += (ov[q].x * ov[q].x + ov[q].y * ov[q].y) + (ov[q].z * ov[q].z + ov[q].w * ov[q].w); }
              ss += __shfl_xor(ss, 1); ss += __shfl_xor(ss, 2); ss += __shfl_xor(ss, 4);
              const float rs = 1.0f / sqrtf(ss * (1.0f / 128.0f) + EPS);
              const v4u g0 = *(const v4u*)(GG + (row0 + row) * 512 + h * 128 + sg * 16), g1 = *(const v4u*)(GG + (row0 + row) * 512 + h * 128 + sg * 16 + 8);
              const f32x4* wp = (const f32x4*)(a.g_gla + sg * 16); const f32x4 w0 = wp[0], w1 = wp[1], w2 = wp[2], w3 = wp[3];
              v4u o0, o1;
              o0.x = pk2(ov[0].x * rs * w0.x * bflo(g0.x), ov[0].y * rs * w0.y * bfhi(g0.x)); o0.y = pk2(ov[0].z * rs * w0.z * bflo(g0.y), ov[0].w * rs * w0.w * bfhi(g0.y));
              o0.z = pk2(ov[1].x * rs * w1.x * bflo(g0.z), ov[1].y * rs * w1.y * bfhi(g0.z)); o0.w = pk2(ov[1].z * rs * w1.z * bflo(g0.w), ov[1].w * rs * w1.w * bfhi(g0.w));
              o1.x = pk2(ov[2].x * rs * w2.x * bflo(g1.x), ov[2].y * rs * w2.y * bfhi(g1.x)); o1.y = pk2(ov[2].z * rs * w2.z * bflo(g1.y), ov[2].w * rs * w2.w * bfhi(g1.y));
              o1.z = pk2(ov[3].x * rs * w3.x * bflo(g1.z), ov[3].y * rs * w3.y * bfhi(g1.z)); o1.w = pk2(ov[3].z * rs * w3.z * bflo(g1.w), ov[3].w * rs * w3.w * bfhi(g1.w));
              bf16* mp = MIX + (row0 + row) * DM + h * 128 + sg * 16; *(v4u*)mp = o0; *(v4u*)(mp + 8) = o1; }
            __syncthreads();
        }
        if (BOTH(4)) GRID_BAR();
    }

    if (IN(5)) {
        pg8::Gemm g{MIX, Wt_out, DM}; pg8::StaticOrder S; S.init(M, DM, G, bid);
        pg8::EpiY E{Y, part};
        pg8::gemm_phase<pg8::EpiY, pg8::StaticOrder>(lds, g, S, E);
        if (BOTH(5)) GRID_BAR();
    }

    if (IN(6)) {
        for (int m = gw; m < M; m += NGW) {
            float p = (lane < 16) ? part[(size_t)m * 16 + lane] : 0.f; p = wave_sum(p);
            const float rs = 1.0f / sqrtf(p * (1.0f / DM) + EPS);
            const f32x4* xr = (const f32x4*)(a.x + (size_t)m * DM) + lane; const v2u* yr = (const v2u*)(Y + (size_t)m * DM) + lane; const f32x4* gr = (const f32x4*)a.g_postmix + lane;
            f32x4* orow = (f32x4*)(a.out + (size_t)m * DM) + lane; v2u* xb = (v2u*)(X1B + (size_t)m * DM) + lane; float s = 0.f;
#pragma unroll
            for (int j = 0; j < 4; ++j) { const f32x4 xv = xr[64 * j], gv = gr[64 * j]; const v2u yw = yr[64 * j];
                f32x4 r; r.x = xv.x + bflo(yw.x) * rs * gv.x; r.y = xv.y + bfhi(yw.x) * rs * gv.y; r.z = xv.z + bflo(yw.y) * rs * gv.z; r.w = xv.w + bfhi(yw.y) * rs * gv.w;
                s += (r.x * r.x + r.y * r.y) + (r.z * r.z + r.w * r.w);
                orow[64 * j] = r; v2u w; w.x = pk2(r.x, r.y); w.y = pk2(r.z, r.w); xb[64 * j] = w; }
            s = wave_sum(s); if (lane == 0) rs1[m] = 1.0f / sqrtf(s * (1.0f / DM) + EPS); }
        if (BOTH(6)) GRID_BAR();
    }

    if (IN(7)) {
        pg8::Gemm g{X1B, Wt_up, DM}; pg8::UpOrder S{G, bid};
        pg8::EpiUp E{ACT, rs1, a.conv_w, a.conv_b};
        pg8::gemm_phase<pg8::EpiUp, pg8::UpOrder>(lds, g, S, E);
        if (BOTH(7)) GRID_BAR();
    }

    if (IN(8)) {
        pg8::Gemm g{ACT, Wt_dn, DFF}; pg8::StaticOrder S; S.init(M, DM, G, bid);
        pg8::EpiY E{Y, part};
        pg8::gemm_phase<pg8::EpiY, pg8::StaticOrder>(lds, g, S, E);
        if (BOTH(8)) GRID_BAR();
    }

    if (IN(9)) {
        for (int m = gw; m < M; m += NGW) {
            float p = (lane < 16) ? part[(size_t)m * 16 + lane] : 0.f; p = wave_sum(p);
            const float rs = 1.0f / sqrtf(p * (1.0f / DM) + EPS);
            const v2u* yr = (const v2u*)(Y + (size_t)m * DM) + lane; const f32x4* gr = (const f32x4*)a.g_postffn + lane; f32x4* orow = (f32x4*)(a.out + (size_t)m * DM) + lane;
#pragma unroll
            for (int j = 0; j < 4; ++j) { const f32x4 xv = orow[64 * j], gv = gr[64 * j]; const v2u yw = yr[64 * j];
                f32x4 r; r.x = xv.x + bflo(yw.x) * rs * gv.x; r.y = xv.y + bfhi(yw.x) * rs * gv.y; r.z = xv.z + bflo(yw.y) * rs * gv.z; r.w = xv.w + bfhi(yw.y) * rs * gv.w;
                orow[64 * j] = r; } }
    }
#undef IN
#undef BOTH
}

constexpr int N_PHASES = 10;

extern "C" void kernel_launch(void* const* d_in, const int* in_sizes, int n_in, void* d_out, int out_size, void* d_ws, size_t ws_size, hipStream_t stream) {
    static int grid = 0;
    if (grid == 0) {
        if (n_in != 16 || in_sizes[0] != M * DM || out_size != M * DM || ws_size < WS_END) { fprintf(stderr, "kernel_launch: unexpected shapes (n_in %d, in0 %d, out %d, ws %zu); nothing launched\n", n_in, n_in > 0 ? in_sizes[0] : -1, out_size, ws_size); grid = -1; return; }
        int dev = 0, cus = 0, per_cu = 0;
        if (hipGetDevice(&dev) != hipSuccess || hipDeviceGetAttribute(&cus, hipDeviceAttributeMultiprocessorCount, dev) != hipSuccess) { grid = -1; return; }
        if (hipFuncSetAttribute((const void*)fwd, hipFuncAttributeMaxDynamicSharedMemorySize, LDS_BYTES) != hipSuccess) { fprintf(stderr, "kernel_launch: hipFuncSetAttribute failed\n"); grid = -1; return; }
        if (hipOccupancyMaxActiveBlocksPerMultiprocessor(&per_cu, (const void*)fwd, NTHREADS, LDS_BYTES) != hipSuccess || per_cu < 1) { fprintf(stderr, "kernel_launch: occupancy query says %d\n", per_cu); per_cu = 1; }
        (void)hipGetLastError();
        grid = cus * (per_cu < 1 ? 1 : per_cu);
        if (grid > cus) grid = cus;
    }
    if (grid < 0) return;
    (void)hipMemsetAsync((char*)d_ws + WS_CTL, 0, CTL_ZERO_BYTES, stream);
    Args a{};
    a.x = (const float*)d_in[0]; a.pos = (const int*)d_in[1]; a.g_pre = (const float*)d_in[2]; a.w_in = (const float*)d_in[3]; a.gate_up = (const float*)d_in[4]; a.gate_bias = (const float*)d_in[5];
    a.g_gla = (const float*)d_in[6]; a.sinks = (const float*)d_in[7]; a.w_out = (const float*)d_in[8]; a.g_postmix = (const float*)d_in[9]; a.g_preffn = (const float*)d_in[10]; a.w_up = (const float*)d_in[11];
    a.conv_w = (const float*)d_in[12]; a.conv_b = (const float*)d_in[13]; a.w_down = (const float*)d_in[14]; a.g_postffn = (const float*)d_in[15];
    a.out = (float*)d_out; a.ws = (unsigned char*)d_ws;
#if MK_ONE_LAUNCH
    a.ph_lo = 0; a.ph_hi = N_PHASES;
    void* args[] = {&a};
    hipError_t e = hipLaunchCooperativeKernel((const void*)fwd, dim3(grid), dim3(NTHREADS), args, LDS_BYTES, stream);
    if (e != hipSuccess) fprintf(stderr, "kernel_launch: cooperative launch failed: %s (grid %d)\n", hipGetErrorString(e), grid);
#else
    for (int p = 0; p < N_PHASES; ++p) { a.ph_lo = p; a.ph_hi = p + 1; hipLaunchKernelGGL(fwd, dim3(grid), dim3(NTHREADS), LDS_BYTES, stream, a); }
#endif
}
```
